# Optimizing an MI355X kernel written in HIP

```python
import math
import jax, jax.numpy as jnp
from jax import lax
import numpy as np

D_MODEL = 2048
BATCH = 2
SEQ = 8192
DEPTH = 1

MEM_LEN = 256
DIFF_HEADS = D_MODEL // 256
DIFF_QK_DIM = 64
DIFF_V_DIM = 2 * DIFF_QK_DIM
SB_HEADS = D_MODEL // 256
SB_DIM = 128
MEM_HEADS = 4
MEM_DIM = D_MODEL // 8
N_BRANCH = 3
N_BUCKETS = 32
MAX_DISTANCE = 128
Q_BLOCK = 128
N_EXPERTS = 32
TOP_K = 4
EXPERT_FF = D_MODEL
SWIGLU_LIMIT = 7.0
SWIGLU_ALPHA = 1.702
MOE_BLOCK = 256
NORM_EPS = 1e-6
NEG_INF = -1e30

DIFF_QK_W = DIFF_HEADS * 2 * DIFF_QK_DIM
DIFF_V_W = DIFF_HEADS * DIFF_V_DIM
SB_W = SB_HEADS * SB_DIM
MEM_W = MEM_HEADS * MEM_DIM
IN_W = 2 * DIFF_QK_W + DIFF_V_W + 3 * SB_W + MEM_W + N_BRANCH * D_MODEL

kernel_name = "hybrid_diffattn_stickbreak_memxattn_moe"


def rms_norm(x, g):
    xf = x.astype(jnp.float32)
    y = xf * lax.rsqrt(jnp.mean(xf * xf, axis=-1, keepdims=True) + NORM_EPS)
    return (y * g.astype(jnp.float32)).astype(x.dtype)


def t5_bucket(n):
    max_exact = N_BUCKETS // 2
    nf = jnp.maximum(n, 1).astype(jnp.float32)
    large = max_exact + (jnp.log(nf / max_exact) / math.log(MAX_DISTANCE / max_exact)
                         * (N_BUCKETS - max_exact)).astype(jnp.int32)
    large = jnp.minimum(large, N_BUCKETS - 1)
    return jnp.where(n < max_exact, n, large)


def diff_attention(q, k, v, rel_bias, lam, lam_init, subln_g):
    B, H, _, S, dq = q.shape
    dv = v.shape[-1]
    scale = dq ** -0.5
    kpos = jnp.arange(S)

    def block(i):
        qb = lax.dynamic_slice_in_dim(q, i * Q_BLOCK, Q_BLOCK, axis=3)
        qpos = i * Q_BLOCK + jnp.arange(Q_BLOCK)
        dist = qpos[:, None] - kpos[None, :]
        bias = rel_bias[t5_bucket(jnp.maximum(dist, 0))]
        bias = jnp.transpose(bias, (2, 0, 1)).astype(jnp.float32)[None, :, None]
        s = jnp.einsum('bhmqd,bhmkd->bhmqk', qb, k).astype(jnp.float32) * scale + bias
        s = jnp.where(dist >= 0, s, NEG_INF)
        p = jax.nn.softmax(s, axis=-1)
        w = p[:, :, 0] - lam * p[:, :, 1]
        return jnp.einsum('bhqk,bhkd->bqhd', w.astype(v.dtype), v)

    o = lax.map(block, jnp.arange(S // Q_BLOCK))
    o = jnp.transpose(o, (1, 0, 2, 3, 4)).reshape(B, S, H, dv)
    o = rms_norm(o, subln_g) * (1.0 - lam_init)
    return o.reshape(B, S, H * dv)


def stick_breaking_attention(q, k, v):
    B, H, S, d = q.shape
    scale = d ** -0.5
    kpos = jnp.arange(S)

    def block(i):
        qb = lax.dynamic_slice_in_dim(q, i * Q_BLOCK, Q_BLOCK, axis=2)
        qpos = i * Q_BLOCK + jnp.arange(Q_BLOCK)
        strict = kpos[None, :] < qpos[:, None]
        z = jnp.einsum('bhqd,bhkd->bhqk', qb, k).astype(jnp.float32) * scale
        log_keep = jnp.where(strict, -jax.nn.softplus(z), 0.0)
        after = lax.cumsum(log_keep, axis=3, reverse=True) - log_keep
        a = jnp.where(strict, jnp.exp(jax.nn.log_sigmoid(z) + after), 0.0)
        return jnp.einsum('bhqk,bhkd->bqhd', a.astype(v.dtype), v)

    o = lax.map(block, jnp.arange(S // Q_BLOCK))
    return jnp.transpose(o, (1, 0, 2, 3, 4)).reshape(B, S, H * d)


def memory_attention(q, k, v):
    B, H, S, d = q.shape
    s = jnp.einsum('bhsd,bhmd->bhsm', q, k).astype(jnp.float32) * (d ** -0.5)
    p = jax.nn.softmax(s, axis=-1)
    o = jnp.einsum('bhsm,bhmd->bshd', p.astype(v.dtype), v)
    return o.reshape(B, S, H * d)


def moe_ffn(h, w_r, b_r, w1, b1, w2, b2):
    T, D = h.shape
    logits = (h @ w_r).astype(jnp.float32) + b_r.astype(jnp.float32)
    top_v, top_i = lax.top_k(logits, TOP_K)
    gates = jax.nn.softmax(top_v, axis=-1)
    N = T * TOP_K
    e_flat = top_i.reshape(N).astype(jnp.int32)
    tok_flat = (jnp.arange(N) // TOP_K).astype(jnp.int32)
    g_flat = gates.reshape(N)
    order = jnp.argsort(e_flat)
    e_sorted = e_flat[order]
    counts = jnp.bincount(e_flat, length=N_EXPERTS).astype(jnp.int32)
    starts = jnp.cumsum(counts) - counts
    padded = ((counts + MOE_BLOCK - 1) // MOE_BLOCK) * MOE_BLOCK
    pad_end = jnp.cumsum(padded).astype(jnp.int32)
    pad_start = pad_end - padded
    dest = pad_start[e_sorted] + (jnp.arange(N, dtype=jnp.int32) - starts[e_sorted])
    n_blocks = -(-N // MOE_BLOCK) + N_EXPERTS
    P = n_blocks * MOE_BLOCK
    row_tok = jnp.full((P,), T, jnp.int32).at[dest].set(tok_flat[order])
    row_gate = jnp.zeros((P,), jnp.float32).at[dest].set(g_flat[order])
    blk_start = jnp.arange(n_blocks, dtype=jnp.int32) * MOE_BLOCK
    blk_exp = jnp.minimum(jnp.searchsorted(pad_end, blk_start, side='right'),
                          N_EXPERTS - 1).astype(jnp.int32)
    h_pad = jnp.concatenate([h, jnp.zeros((1, D), h.dtype)], axis=0)
    xs = h_pad[row_tok].reshape(n_blocks, MOE_BLOCK, D)

    def expert_block(args):
        xb, e = args
        a = xb @ w1[e] + b1[e]
        a_glu, a_lin = jnp.split(a, 2, axis=-1)
        a_glu = jnp.minimum(a_glu, SWIGLU_LIMIT)
        a_lin = jnp.clip(a_lin, -SWIGLU_LIMIT, SWIGLU_LIMIT)
        act = a_glu * jax.nn.sigmoid(SWIGLU_ALPHA * a_glu) * (a_lin + 1.0)
        return act @ w2[e] + b2[e]

    ys = lax.map(expert_block, (xs, blk_exp)).reshape(P, D)
    ys = ys.astype(jnp.float32) * row_gate[:, None]
    out = jnp.zeros((T + 1, D), jnp.float32).at[row_tok].add(ys)[:T]
    return out.astype(h.dtype)


def setup_inputs(seed: int = 0) -> dict:
    key = jax.random.key(seed)
    ks = jax.random.split(key, 26)
    f32 = jnp.float32
    L, D = DEPTH, D_MODEL

    def nrm(k, shape, scale):
        return jax.random.normal(k, shape, f32) * scale

    return {
        "x": nrm(ks[0], (BATCH, SEQ, D), 1.0),
        "mem": nrm(ks[1], (BATCH, MEM_LEN, D), 1.0),
        "g_mix": 1.0 + nrm(ks[2], (L, D), 0.01),
        "w_in": nrm(ks[3], (L, D, IN_W), D ** -0.5),
        "b_gate": nrm(ks[4], (L, N_BRANCH * D), 0.01),
        "rel_bias": nrm(ks[5], (N_BUCKETS, DIFF_HEADS), 0.1),
        "lambda_q1": nrm(ks[6], (L, DIFF_QK_DIM), 0.1),
        "lambda_k1": nrm(ks[7], (L, DIFF_QK_DIM), 0.1),
        "lambda_q2": nrm(ks[8], (L, DIFF_QK_DIM), 0.1),
        "lambda_k2": nrm(ks[9], (L, DIFF_QK_DIM), 0.1),
        "diff_subln_g": 1.0 + nrm(ks[10], (L, DIFF_V_DIM), 0.01),
        "g_mem": 1.0 + nrm(ks[11], (L, D), 0.01),
        "w_mem_kv": nrm(ks[12], (L, D, 2 * MEM_W), D ** -0.5),
        "w_br_diff": nrm(ks[13], (L, DIFF_V_W, D), DIFF_V_W ** -0.5),
        "w_br_sb": nrm(ks[14], (L, SB_W, D), SB_W ** -0.5),
        "w_br_mem": nrm(ks[15], (L, MEM_W, D), MEM_W ** -0.5),
        "w_out": nrm(ks[16], (L, D, D), D ** -0.5),
        "g_ffn": 1.0 + nrm(ks[17], (L, D), 0.01),
        "w_router": nrm(ks[18], (L, D, N_EXPERTS), D ** -0.5),
        "b_router": nrm(ks[19], (L, N_EXPERTS), 0.01),
        "w_exp1": nrm(ks[20], (L, N_EXPERTS, D, 2 * EXPERT_FF), D ** -0.5),
        "b_exp1": nrm(ks[21], (L, N_EXPERTS, 2 * EXPERT_FF), 0.01),
        "w_exp2": nrm(ks[22], (L, N_EXPERTS, EXPERT_FF, D), EXPERT_FF ** -0.5),
        "b_exp2": nrm(ks[23], (L, N_EXPERTS, D), 0.01),
        "g_final": 1.0 + nrm(ks[24], (D,), 0.01),
    }


def reference(x, mem, g_mix, w_in, b_gate, rel_bias, lambda_q1, lambda_k1, lambda_q2,
              lambda_k2, diff_subln_g, g_mem, w_mem_kv, w_br_diff, w_br_sb, w_br_mem,
              w_out, g_ffn, w_router, b_router, w_exp1, b_exp1, w_exp2, b_exp2, g_final):
    B, S, D = x.shape
    cuts = np.cumsum([DIFF_QK_W, DIFF_QK_W, DIFF_V_W, SB_W, SB_W, SB_W, MEM_W]).tolist()
    for l in range(DEPTH):
        h = rms_norm(x, g_mix[l])
        proj = h @ w_in[l]
        dq, dk, dv, sq, sk, sv, mq, gl = jnp.split(proj, cuts, axis=-1)
        dq = dq.reshape(B, S, DIFF_HEADS, 2, DIFF_QK_DIM).transpose(0, 2, 3, 1, 4)
        dk = dk.reshape(B, S, DIFF_HEADS, 2, DIFF_QK_DIM).transpose(0, 2, 3, 1, 4)
        dv = dv.reshape(B, S, DIFF_HEADS, DIFF_V_DIM).transpose(0, 2, 1, 3)
        sq = sq.reshape(B, S, SB_HEADS, SB_DIM).transpose(0, 2, 1, 3)
        sk = sk.reshape(B, S, SB_HEADS, SB_DIM).transpose(0, 2, 1, 3)
        sv = sv.reshape(B, S, SB_HEADS, SB_DIM).transpose(0, 2, 1, 3)
        mq = mq.reshape(B, S, MEM_HEADS, MEM_DIM).transpose(0, 2, 1, 3)
        gates = jax.nn.sigmoid((gl + b_gate[l]).astype(jnp.float32)).astype(x.dtype)
        g_a, g_b, g_c = jnp.split(gates, N_BRANCH, axis=-1)

        lam_init = 0.8 - 0.6 * math.exp(-0.3 * l)
        lam = (jnp.exp(jnp.sum(lambda_q1[l].astype(jnp.float32) * lambda_k1[l].astype(jnp.float32)))
               - jnp.exp(jnp.sum(lambda_q2[l].astype(jnp.float32) * lambda_k2[l].astype(jnp.float32)))
               + lam_init)
        y_a = diff_attention(dq, dk, dv, rel_bias, lam, lam_init, diff_subln_g[l])
        y_b = stick_breaking_attention(sq, sk, sv)
        kv = rms_norm(mem, g_mem[l]) @ w_mem_kv[l]
        mk, mv = jnp.split(kv, 2, axis=-1)
        M = mem.shape[1]
        mk = mk.reshape(B, M, MEM_HEADS, MEM_DIM).transpose(0, 2, 1, 3)
        mv = mv.reshape(B, M, MEM_HEADS, MEM_DIM).transpose(0, 2, 1, 3)
        y_c = memory_attention(mq, mk, mv)

        merged = (g_a * (y_a @ w_br_diff[l]) + g_b * (y_b @ w_br_sb[l])
                  + g_c * (y_c @ w_br_mem[l]))
        x = x + merged @ w_out[l]

        h2 = rms_norm(x, g_ffn[l]).reshape(B * S, D)
        y = moe_ffn(h2, w_router[l], b_router[l], w_exp1[l], b_exp1[l], w_exp2[l], b_exp2[l])
        x = x + y.reshape(B, S, D)
    return rms_norm(x, g_final)
```

```cpp
#include <hip/hip_runtime.h>
#include <cstdio>
#include <cstdint>
constexpr int LD_D = 2048 + 64;
constexpr int LD_Y = 3072 + 64;
constexpr int LD_P = 13312 + 64;
constexpr int LD_F8 = 2048 + 128;
namespace pg8 {
#define PG8_LAS __attribute__((address_space(3)))
typedef unsigned short bf16_t;
typedef short bf16x8 __attribute__((ext_vector_type(8)));
typedef float f32x4 __attribute__((ext_vector_type(4)));
typedef unsigned u32x4 __attribute__((ext_vector_type(4)));
constexpr int BM = 256, BK = 64, HALF = 128, HTB = HALF * BK * 2  , STAGE_BYTES = 8 * HTB, NXCD = 8, WGM = 8;

__host__ __device__ __forceinline__ int lds_byte(int r, int c) { const int st = (r >> 4) * 2 + (c >> 5), rr = r & 15, cc = c & 31, ob = rr * 64 + cc * 2; return st * 1024 + (ob ^ (((ob >> 9) & 1) << 5)); }
__host__ __device__ __forceinline__ void stage_rc(int b, int& R, int& C) { const int st = b / 1024, sb = b % 1024, swz = sb ^ (((sb >> 9) & 1) << 5); R = (st >> 1) * 16 + swz / 64; C = (st & 1) * 32 + (swz % 64) / 2; }
__host__ __device__ __forceinline__ int perm32(int rho) { const int n = rho >> 4, i = rho & 15; return 8 * (i >> 2) + 4 * n + (i & 3); }

typedef int i32x8 __attribute__((ext_vector_type(8))); typedef int i32x4 __attribute__((ext_vector_type(4)));
__device__ __forceinline__ i32x8 pg8_cat(bf16x8 lo, bf16x8 hi) { const i32x4 a = __builtin_bit_cast(i32x4, lo), b = __builtin_bit_cast(i32x4, hi); return __builtin_shufflevector(a, b, 0, 1, 2, 3, 4, 5, 6, 7); }
struct Unit { int pm, pn; };
struct Gemm { const bf16_t* A; const bf16_t* Bt; int M, N, K; int sa, sb; int lda, ldb; };

struct StaticOrder {
    int nM, nN, nwg, G, c;
    __host__ __device__ void init(int M, int N, int G_, int c_) { nM = M / BM; nN = N / BM; nwg = nM * nN; G = G_; c = c_; }
    __host__ __device__ bool next(int i, Unit& u) const {
        const long L = (long)i * G + c; if (L >= nwg) return false;
        int wgid = (int)L; { const int q = nwg / NXCD, r = nwg % NXCD, xcd = wgid % NXCD, off = wgid / NXCD; wgid = (xcd < r ? xcd * (q + 1) : r * (q + 1) + (xcd - r) * q) + off; }
        const int nig = WGM * nN, gid = wgid / nig, fm = gid * WGM, gsz = (nM - fm) < WGM ? (nM - fm) : WGM;
        u.pm = fm + ((wgid % nig) % gsz); u.pn = (wgid % nig) / gsz; return true;
    }
    __device__ __forceinline__ void a_ready(const Unit&) const {}
    __device__ __forceinline__ void done(const Unit&) const {}
};

__device__ __forceinline__ unsigned cvt_pk_bf16(float lo, float hi) { unsigned r; asm volatile("v_cvt_pk_bf16_f32 %0, %1, %2" : "=v"(r) : "v"(lo), "v"(hi)); return r; }
typedef float f32x2 __attribute__((ext_vector_type(2)));
__device__ __forceinline__ f32x2 gelu_pk(f32x2 v) {
    const f32x2 av = __builtin_elementwise_abs(v), d = av * 0.2316418882f + 1.0f;
    f32x2 t; t.x = __builtin_amdgcn_rcpf(d.x); t.y = __builtin_amdgcn_rcpf(d.y);
    f32x2 q = t * 0.5307027145f + (-0.7265760135f); q = q * t + 0.7107068705f; q = q * t + (-0.142248368f); q = q * t + 0.127414796f; q = q * t;
    const f32x2 s = (v * v) * (-0.72134752044f);
    f32x2 e; e.x = __builtin_amdgcn_exp2f(s.x); e.y = __builtin_amdgcn_exp2f(s.y);
    const f32x2 m = v * (q * e), r = v - m;
    f32x2 o; o.x = v.x < 0.f ? m.x : r.x; o.y = v.y < 0.f ? m.y : r.y; return o;
}

template <int ACT  > struct EpiBf16 {
    static constexpr bool PERM = true, AFTER_DRAIN = false, MIDK = false; static_assert(ACT == 0 || ACT == 1, "EpiBf16: ACT is 0 (none) or 1 (gelu_pk)");
    bf16_t* O; int ldc; const float* bias; int split_cols; size_t split_stride; float scale0;
    struct Pre {}; __device__ __forceinline__ Pre prefetch(const Unit&, int, int, int, int) const { return Pre{}; }
    __device__ __forceinline__ void operator()(const f32x4 (&acc)[2][2][4][2], const Unit& u, int wr, int wc, int fr, int fq, const Pre&) const {
        const int row0 = u.pm * BM + wr * 64 + fr; int colt = u.pn * BM; bf16_t* base = O;
        float sc = 1.f; if (split_cols) { const int t = colt / split_cols; base += (size_t)t * split_stride; colt -= t * split_cols; if (t == 0) sc = scale0; }
        const int col0 = colt + wc * 32 + 8 * fq, bcol0 = u.pn * BM + wc * 32 + 8 * fq;
        f32x4 bv[2][2];
#pragma unroll
        for (int bj = 0; bj < 2; ++bj)
#pragma unroll
            for (int n = 0; n < 2; ++n) bv[bj][n] = bias ? *(const f32x4*)(bias + bcol0 + bj * HALF + 4 * n) : (f32x4){0.f, 0.f, 0.f, 0.f};
#pragma unroll
        for (int ai = 0; ai < 2; ++ai)
#pragma unroll
            for (int m = 0; m < 4; ++m) { bf16_t* rowp = base + (size_t)(row0 + ai * HALF + m * 16) * ldc + col0;
#pragma unroll
                for (int bj = 0; bj < 2; ++bj) { f32x4 v0 = acc[ai][bj][m][0] + bv[bj][0], v1 = acc[ai][bj][m][1] + bv[bj][1];
                    if (ACT == 1) { f32x2 a = gelu_pk((f32x2){v0[0], v0[1]}), b = gelu_pk((f32x2){v0[2], v0[3]}), c = gelu_pk((f32x2){v1[0], v1[1]}), d = gelu_pk((f32x2){v1[2], v1[3]});
                        v0 = (f32x4){a.x, a.y, b.x, b.y}; v1 = (f32x4){c.x, c.y, d.x, d.y}; }
                    v0 = v0 * sc; v1 = v1 * sc; u32x4 w; w.x = cvt_pk_bf16(v0[0], v0[1]); w.y = cvt_pk_bf16(v0[2], v0[3]); w.z = cvt_pk_bf16(v1[0], v1[1]); w.w = cvt_pk_bf16(v1[2], v1[3]);
                    *(u32x4*)(rowp + bj * HALF) = w; } }
    }
};
constexpr int INW_ = 13312, CG_ = 7168;
constexpr float LOG2E_ = 1.4426950408889634f;
__device__ __forceinline__ void ld_bf16x8(const bf16_t* p, float (&f)[8]) {
    const u32x4 w = *(const u32x4*)p;
    f[0] = __uint_as_float(w.x << 16); f[1] = __uint_as_float(w.x & 0xffff0000u); f[2] = __uint_as_float(w.y << 16); f[3] = __uint_as_float(w.y & 0xffff0000u);
    f[4] = __uint_as_float(w.z << 16); f[5] = __uint_as_float(w.z & 0xffff0000u); f[6] = __uint_as_float(w.w << 16); f[7] = __uint_as_float(w.w & 0xffff0000u);
}
template <bool GATES> struct EpiProjT {
    static constexpr bool PERM = true, AFTER_DRAIN = false, MIDK = false;
    bf16_t* O; const float* b_gate;
    struct Pre { f32x4 bv[GATES ? 2 : 1][2]; };
    __device__ __forceinline__ Pre prefetch(const Unit& u, int wr, int wc, int fr, int fq) const {
        Pre p; const int col0 = u.pn * BM + wc * 32 + 8 * fq; const bool gate = GATES && u.pn >= CG_ / BM;
#pragma unroll
        for (int bj = 0; bj < (GATES ? 2 : 1); ++bj)
#pragma unroll
            for (int n = 0; n < 2; ++n) p.bv[bj][n] = gate ? *(const f32x4*)(b_gate + (col0 - CG_) + bj * HALF + 4 * n) : (f32x4){0.f, 0.f, 0.f, 0.f};
        return p;
    }
    __device__ __forceinline__ void operator()(const f32x4 (&acc)[2][2][4][2], const Unit& u, int wr, int wc, int fr, int fq, const Pre& pre) const {
        const int row0 = u.pm * BM + wr * 64 + fr, col0 = u.pn * BM + wc * 32 + 8 * fq;
        const bool gate = GATES && u.pn >= CG_ / BM;
        float sc = 1.f;
        if (u.pn < 4) sc = 0.125f * LOG2E_; else if (u.pn >= 12 && u.pn < 16) sc = 0.08838834764831845f * LOG2E_; else if (u.pn >= 24 && u.pn < 28) sc = 0.0625f * LOG2E_;
#pragma unroll
        for (int ai = 0; ai < 2; ++ai)
#pragma unroll
            for (int m = 0; m < 4; ++m) { bf16_t* rowp = O + (size_t)(row0 + ai * HALF + m * 16) * LD_P + col0;
#pragma unroll
                for (int bj = 0; bj < 2; ++bj) { f32x4 v0 = acc[ai][bj][m][0], v1 = acc[ai][bj][m][1];
                    if (gate) { v0 = v0 + pre.bv[GATES ? bj : 0][0]; v1 = v1 + pre.bv[GATES ? bj : 0][1];
#pragma unroll
                        for (int j = 0; j < 4; ++j) { v0[j] = __builtin_amdgcn_rcpf(1.0f + __builtin_amdgcn_exp2f(-LOG2E_ * v0[j])); v1[j] = __builtin_amdgcn_rcpf(1.0f + __builtin_amdgcn_exp2f(-LOG2E_ * v1[j])); } }
                    else { v0 = v0 * sc; v1 = v1 * sc; }
                    u32x4 w; w.x = cvt_pk_bf16(v0[0], v0[1]); w.y = cvt_pk_bf16(v0[2], v0[3]); w.z = cvt_pk_bf16(v1[0], v1[1]); w.w = cvt_pk_bf16(v1[2], v1[3]);
                    *(u32x4*)(rowp + bj * HALF) = w; } }
    }
};
typedef EpiProjT<true> EpiProj; typedef EpiProjT<false> EpiProjQ;

template <bool OUT8> struct EpiMergedT {
    static constexpr bool PERM = true, AFTER_DRAIN = false, MIDK = true; static constexpr int MID0 = 16, MID1 = 32;
    bf16_t* O; const bf16_t* gates;
    __device__ __forceinline__ void mid(f32x4 (&acc)[2][2][4][2], const Unit& u, int t, int wr, int wc, int fr, int fq) const {
        int row0 = u.pm * BM + wr * 64 + fr; asm volatile("" : "+v"(row0));
        const int col0 = u.pn * BM + wc * 32 + 8 * fq; const int gn = (t == MID0) ? 0 : 2048;
        u32x4 gnum[2][2][2], gden[2][2][2];
#define MID_LOAD(q, B) do { _Pragma("unroll") for (int mm = 0; mm < 2; ++mm) { const bf16_t* gp = gates + (size_t)(row0 + ((q) >> 1) * HALF + (2 * ((q) & 1) + mm) * 16) * LD_P + col0 + gn; \
            _Pragma("unroll") for (int bj = 0; bj < 2; ++bj) { gnum[B][mm][bj] = *(const u32x4*)(gp + bj * HALF); gden[B][mm][bj] = *(const u32x4*)(gp + 2048 + bj * HALF); } } asm volatile("" ::: "memory"); } while (0)
#define MID_APPLY(q, B) do { _Pragma("unroll") for (int mm = 0; mm < 2; ++mm) _Pragma("unroll") for (int bj = 0; bj < 2; ++bj) { const u32x4 a = gnum[B][mm][bj], b = gden[B][mm][bj]; \
            const float an[8] = {__uint_as_float(a.x << 16), __uint_as_float(a.x & 0xffff0000u), __uint_as_float(a.y << 16), __uint_as_float(a.y & 0xffff0000u), __uint_as_float(a.z << 16), __uint_as_float(a.z & 0xffff0000u), __uint_as_float(a.w << 16), __uint_as_float(a.w & 0xffff0000u)}; \
            const float bn[8] = {__uint_as_float(b.x << 16), __uint_as_float(b.x & 0xffff0000u), __uint_as_float(b.y << 16), __uint_as_float(b.y & 0xffff0000u), __uint_as_float(b.z << 16), __uint_as_float(b.z & 0xffff0000u), __uint_as_float(b.w << 16), __uint_as_float(b.w & 0xffff0000u)}; \
            _Pragma("unroll") for (int j = 0; j < 4; ++j) { acc[(q) >> 1][bj][2 * ((q) & 1) + mm][0][j] *= an[j] * __builtin_amdgcn_rcpf(fmaxf(bn[j], 1e-30f)); acc[(q) >> 1][bj][2 * ((q) & 1) + mm][1][j] *= an[4 + j] * __builtin_amdgcn_rcpf(fmaxf(bn[4 + j], 1e-30f)); } } \
            asm volatile("" ::: "memory"); } while (0)
        MID_LOAD(0, 0); MID_LOAD(1, 1); MID_APPLY(0, 0); MID_LOAD(2, 0); MID_APPLY(1, 1); MID_LOAD(3, 1); MID_APPLY(2, 0); MID_APPLY(3, 1);
#undef MID_LOAD
#undef MID_APPLY
    }
    struct Pre {}; __device__ __forceinline__ Pre prefetch(const Unit&, int, int, int, int) const { return Pre{}; }
    __device__ __forceinline__ void operator()(const f32x4 (&acc)[2][2][4][2], const Unit& u, int wr, int wc, int fr, int fq, const Pre&) const {
        const int row0 = u.pm * BM + wr * 64 + fr, col0 = u.pn * BM + wc * 32 + 8 * fq;
#pragma unroll
        for (int ai = 0; ai < 2; ++ai)
#pragma unroll
            for (int m = 0; m < 4; ++m) { const size_t r = (size_t)(row0 + ai * HALF + m * 16); const bf16_t* gp = gates + r * LD_P + col0 + 4096; bf16_t* rowp = O + r * LD_D + col0;
#pragma unroll
                for (int bj = 0; bj < 2; ++bj) { float g[8]; ld_bf16x8(gp + bj * HALF, g); const f32x4 v0 = acc[ai][bj][m][0], v1 = acc[ai][bj][m][1];
                    if constexpr (OUT8) { int w0 = 0, w1 = 0;
                        w0 = __builtin_amdgcn_cvt_pk_fp8_f32(__builtin_amdgcn_fmed3f(16.f * v0[0] * g[0], -448.f, 448.f), __builtin_amdgcn_fmed3f(16.f * v0[1] * g[1], -448.f, 448.f), w0, false);
                        w0 = __builtin_amdgcn_cvt_pk_fp8_f32(__builtin_amdgcn_fmed3f(16.f * v0[2] * g[2], -448.f, 448.f), __builtin_amdgcn_fmed3f(16.f * v0[3] * g[3], -448.f, 448.f), w0, true);
                        w1 = __builtin_amdgcn_cvt_pk_fp8_f32(__builtin_amdgcn_fmed3f(16.f * v1[0] * g[4], -448.f, 448.f), __builtin_amdgcn_fmed3f(16.f * v1[1] * g[5], -448.f, 448.f), w1, false);
                        w1 = __builtin_amdgcn_cvt_pk_fp8_f32(__builtin_amdgcn_fmed3f(16.f * v1[2] * g[6], -448.f, 448.f), __builtin_amdgcn_fmed3f(16.f * v1[3] * g[7], -448.f, 448.f), w1, true);
                        typedef int i32x2_t __attribute__((ext_vector_type(2)));
                        *(i32x2_t*)((unsigned char*)O + r * LD_F8 + col0 + bj * HALF) = (i32x2_t){w0, w1}; }
                    else { u32x4 w; w.x = cvt_pk_bf16(v0[0] * g[0], v0[1] * g[1]); w.y = cvt_pk_bf16(v0[2] * g[2], v0[3] * g[3]); w.z = cvt_pk_bf16(v1[0] * g[4], v1[1] * g[5]); w.w = cvt_pk_bf16(v1[2] * g[6], v1[3] * g[7]);
                        *(u32x4*)(rowp + bj * HALF) = w; } } }
    }
};
typedef EpiMergedT<false> EpiMerged; typedef EpiMergedT<true> EpiMerged8;
struct EpiResid {
    static constexpr bool PERM = false, AFTER_DRAIN = false, MIDK = false;
    const float* X; float* O;
    struct Pre {}; __device__ __forceinline__ Pre prefetch(const Unit&, int, int, int, int) const { return Pre{}; }
    __device__ __forceinline__ void operator()(const f32x4 (&acc)[2][2][4][2], const Unit& u, int wr, int wc, int fr, int fq, const Pre&) const {
        const int col0 = u.pn * BM + wc * 32 + 4 * fq;
#pragma unroll
        for (int ai = 0; ai < 2; ++ai)
#pragma unroll
            for (int m = 0; m < 4; ++m) { const size_t off = (size_t)(u.pm * BM + ai * HALF + wr * 64 + m * 16 + fr) * 2048 + col0;
#pragma unroll
                for (int bj = 0; bj < 2; ++bj)
#pragma unroll
                    for (int n = 0; n < 2; ++n) { const f32x4 xv = __builtin_nontemporal_load((const f32x4*)(X + off + bj * HALF + n * 16)); *(f32x4*)(O + off + bj * HALF + n * 16) = xv + acc[ai][bj][m][n]; } }
    }
};
struct EpiSwiglu {
    static constexpr bool PERM = true, AFTER_DRAIN = false, MIDK = false;
    unsigned char* O; const float* b1;
    struct Pre { f32x4 bg[2], bl[2]; };
    __device__ __forceinline__ Pre prefetch(const Unit& u, int wr, int wc, int fr, int fq) const {
        Pre p; const int e = u.pn >> 4, nt = u.pn & 15, col0 = nt * 128 + wc * 32 + 8 * fq;
#pragma unroll
        for (int n = 0; n < 2; ++n) { p.bg[n] = *(const f32x4*)(b1 + (size_t)e * 4096 + col0 + 4 * n); p.bl[n] = *(const f32x4*)(b1 + (size_t)e * 4096 + 2048 + col0 + 4 * n); }
        return p;
    }
    __device__ __forceinline__ void operator()(const f32x4 (&acc)[2][2][4][2], const Unit& u, int wr, int wc, int fr, int fq, const Pre& pre) const {
        const int nt = u.pn & 15, row0 = u.pm * BM + wr * 64 + fr, col0 = nt * 128 + wc * 32 + 8 * fq;
        const f32x4 bg[2] = {pre.bg[0], pre.bg[1]}, bl[2] = {pre.bl[0], pre.bl[1]};
#pragma unroll
        for (int ai = 0; ai < 2; ++ai)
#pragma unroll
            for (int m = 0; m < 4; ++m) { unsigned char* rowp = O + (size_t)(row0 + ai * HALF + m * 16) * LD_F8 + col0; float r[8];
#pragma unroll
                for (int n = 0; n < 2; ++n) { const f32x4 ga = acc[ai][0][m][n], la = acc[ai][1][m][n];
#pragma unroll
                    for (int h = 0; h < 2; ++h) {
                        f32x2 g = (f32x2){ga[2 * h], ga[2 * h + 1]} + (f32x2){bg[n][2 * h], bg[n][2 * h + 1]}, l = (f32x2){la[2 * h], la[2 * h + 1]} + (f32x2){bl[n][2 * h], bl[n][2 * h + 1]};
                        g.x = fminf(g.x, 7.0f); g.y = fminf(g.y, 7.0f); l.x = __builtin_amdgcn_fmed3f(l.x, -7.0f, 7.0f); l.y = __builtin_amdgcn_fmed3f(l.y, -7.0f, 7.0f);
                        f32x2 t = g * (-1.702f * LOG2E_); t.x = __builtin_amdgcn_exp2f(t.x); t.y = __builtin_amdgcn_exp2f(t.y);
                        t = t + 1.0f; t.x = __builtin_amdgcn_rcpf(t.x); t.y = __builtin_amdgcn_rcpf(t.y);
                        const f32x2 o = (g * t) * (l * 4.0f + 4.0f);
                        r[4 * n + 2 * h] = o.x; r[4 * n + 2 * h + 1] = o.y; } }
                int w0 = 0, w1 = 0;
                w0 = __builtin_amdgcn_cvt_pk_fp8_f32(r[0], r[1], w0, false); w0 = __builtin_amdgcn_cvt_pk_fp8_f32(r[2], r[3], w0, true);
                w1 = __builtin_amdgcn_cvt_pk_fp8_f32(r[4], r[5], w1, false); w1 = __builtin_amdgcn_cvt_pk_fp8_f32(r[6], r[7], w1, true);
                typedef int i32x2_t __attribute__((ext_vector_type(2)));
                *(i32x2_t*)rowp = (i32x2_t){w0, w1}; }
    }
};
struct EpiYs8 {
    static constexpr bool PERM = true, AFTER_DRAIN = false, MIDK = false;
    unsigned char* O; const float* b2;
    struct Pre { f32x4 bv[2][2]; };
    __device__ __forceinline__ Pre prefetch(const Unit& u, int wr, int wc, int fr, int fq) const {
        Pre p; const int e = u.pn >> 3, nt = u.pn & 7, col0 = nt * BM + wc * 32 + 8 * fq;
#pragma unroll
        for (int bj = 0; bj < 2; ++bj)
#pragma unroll
            for (int n = 0; n < 2; ++n) p.bv[bj][n] = *(const f32x4*)(b2 + (size_t)e * 2048 + col0 + bj * HALF + 4 * n);
        return p;
    }
    __device__ __forceinline__ void operator()(const f32x4 (&acc)[2][2][4][2], const Unit& u, int wr, int wc, int fr, int fq, const Pre& pre) const {
        const int nt = u.pn & 7, row0 = u.pm * BM + wr * 64 + fr, col0 = nt * BM + wc * 32 + 8 * fq;
        f32x4 bv[2][2];
#pragma unroll
        for (int bj = 0; bj < 2; ++bj)
#pragma unroll
            for (int n = 0; n < 2; ++n) bv[bj][n] = pre.bv[bj][n] * 16.0f;
#pragma unroll
        for (int ai = 0; ai < 2; ++ai)
#pragma unroll
            for (int m = 0; m < 4; ++m) { unsigned char* rowp = O + (size_t)(row0 + ai * HALF + m * 16) * 2048 + col0;
#pragma unroll
                for (int bj = 0; bj < 2; ++bj) { f32x2 v[4];
#pragma unroll
                    for (int n = 0; n < 2; ++n)
#pragma unroll
                        for (int h = 0; h < 2; ++h) { const f32x4 a = acc[ai][bj][m][n]; f32x2 t = (f32x2){a[2 * h], a[2 * h + 1]} * 16.0f + (f32x2){bv[bj][n][2 * h], bv[bj][n][2 * h + 1]};
                            t.x = __builtin_amdgcn_fmed3f(t.x, -448.f, 448.f); t.y = __builtin_amdgcn_fmed3f(t.y, -448.f, 448.f); v[2 * n + h] = t; }
                    int w0 = 0, w1 = 0;
                    w0 = __builtin_amdgcn_cvt_pk_fp8_f32(v[0].x, v[0].y, w0, false); w0 = __builtin_amdgcn_cvt_pk_fp8_f32(v[1].x, v[1].y, w0, true);
                    w1 = __builtin_amdgcn_cvt_pk_fp8_f32(v[2].x, v[2].y, w1, false); w1 = __builtin_amdgcn_cvt_pk_fp8_f32(v[3].x, v[3].y, w1, true);
                    typedef int i32x2_t __attribute__((ext_vector_type(2)));
                    *(i32x2_t*)(rowp + bj * HALF) = (i32x2_t){w0, w1}; } }
    }
};
__host__ __device__ __forceinline__ int nth_bit(unsigned long long mask, int n) { int pos = 0; for (;;) { if (mask & 1ull) { if (n == 0) return pos; --n; } mask >>= 1; ++pos; } }
struct GateOrder {
    StaticOrder S; unsigned long long mask;
    __device__ __forceinline__ bool next(int i, Unit& u) const { if (!S.next(i, u)) return false; u.pn = nth_bit(mask, u.pn); return true; }
    __device__ __forceinline__ void a_ready(const Unit&) const {}
    __device__ __forceinline__ void done(const Unit&) const {}
};
struct KvOrder {
    int c;
    __device__ __forceinline__ bool next(int i, Unit& u) const { if (i > 0 || c >= 16) return false; u.pm = c >> 3; u.pn = c & 7; return true; }
    __device__ __forceinline__ void a_ready(const Unit&) const {}
    __device__ __forceinline__ void done(const Unit&) const {}
};
struct MoeOrder {
    const PG8_LAS int* tile0; int nN, G, c;
    __device__ __forceinline__ bool next(int i, Unit& u) const {
        const int L = i * G + c; const int tot = __builtin_amdgcn_readfirstlane(tile0[32]) * nN; if (L >= tot) return false;
        int e = 0;
#pragma unroll 1
        for (int k = 1; k < 32; ++k) e += (L >= __builtin_amdgcn_readfirstlane(tile0[k]) * nN) ? 1 : 0;
        const int t0 = __builtin_amdgcn_readfirstlane(tile0[e]), me = __builtin_amdgcn_readfirstlane(tile0[e + 1]) - t0, rem = L - t0 * nN;
        u.pm = t0 + rem % me; u.pn = e * nN + rem / me; return true;
    }
    __device__ __forceinline__ void a_ready(const Unit&) const {}
    __device__ __forceinline__ void done(const Unit&) const {}
};
struct MoeTabOrder {
    const PG8_LAS int* tab;
    __device__ __forceinline__ bool next(int i, Unit& u) const {
        const int pm = __builtin_amdgcn_readfirstlane(tab[2 * i]); if (pm < 0) return false;
        u.pm = pm; u.pn = __builtin_amdgcn_readfirstlane(tab[2 * i + 1]); return true; }
    __device__ __forceinline__ void a_ready(const Unit&) const {}
    __device__ __forceinline__ void done(const Unit&) const {}
};
template <class Epi, class Sched, bool ALIGN_EPI = false, bool SP2 = false, bool FP8 = false, bool ZK = false>
__device__ __forceinline__ void gemm_phase(PG8_LAS unsigned char* lds, const Gemm g, const Sched& S, const Epi& E) {
    const int tid = threadIdx.x, wid = __builtin_amdgcn_readfirstlane(tid >> 6), lane = tid & 63, wr = wid >> 2, wc = wid & 3, fr = lane & 15, fq = lane >> 4;
    const int K = g.K, nt = K / BK;
    unsigned voffA[2], voffB[2];
#pragma unroll
    for (int i = 0; i < 2; ++i) { int R, C; stage_rc(tid * 16 + i * 8192, R, C); const int Rb = Epi::PERM ? ((R & ~31) + perm32(R & 31)) : R;
        voffA[i] = (unsigned)(R * g.lda + C) * 2u; voffB[i] = (unsigned)(Rb * g.ldb + C) * 2u; }
    const size_t kstep = (size_t)(BK * 2);
    const size_t hstepA = (size_t)HALF * g.lda * 2, hstepB = (size_t)HALF * g.ldb * 2;
    const size_t tstepA = 2 * hstepA, tstepB = 2 * hstepB;
    const unsigned ldsw = (unsigned)wid * 1024u;
    const int aoff = lds_byte(wr * 64 + fr, fq * 8), boff = lds_byte(wc * 32 + fr, fq * 8);
#define PG8_SA(b, h) (((b) * 2 + (h)) * HTB)
#define PG8_SB(b, h) ((4 + (b) * 2 + (h)) * HTB)
#define PG8_STAGE(bufoff, gbase, voff) do { _Pragma("unroll") for (int _i = 0; _i < 2; ++_i) \
        __builtin_amdgcn_global_load_lds((const unsigned*)((const char*)(gbase) + (voff)[_i]), (PG8_LAS unsigned*)(lds + (bufoff) + ldsw + _i * 8192), 16, 0, 0); } while (0)
#define PG8_LDA(dst, b, h) do { _Pragma("unroll") for (int m = 0; m < 4; ++m) _Pragma("unroll") for (int k = 0; k < 2; ++k) dst[m][k] = *(const PG8_LAS bf16x8*)(lds + PG8_SA(b, h) + aoff + m * 2048 + k * 1024); } while (0)
#define PG8_LDB(dst, b, h) do { _Pragma("unroll") for (int n = 0; n < 2; ++n) _Pragma("unroll") for (int k = 0; k < 2; ++k) dst[n][k] = *(const PG8_LAS bf16x8*)(lds + PG8_SB(b, h) + boff + n * 2048 + k * 1024); } while (0)
#define PG8_MMA(ai, bj, At, Bt) do { __builtin_amdgcn_s_setprio(1); _Pragma("unroll") for (int m = 0; m < 4; ++m) _Pragma("unroll") for (int n = 0; n < 2; ++n) { \
        if constexpr (FP8) { asm volatile("v_mfma_scale_f32_16x16x128_f8f6f4 %0, %1, %2, %0, %3, %4 op_sel_hi:[0,0,0]" : "+v"(acc[ai][bj][m][n]) : "v"(pg8_cat(Bt[n][0], Bt[n][1])), "v"(pg8_cat(At[m][0], At[m][1])), "v"(vsb), "v"(vsa)); } \
        else { _Pragma("unroll") for (int k = 0; k < 2; ++k) acc[ai][bj][m][n] = __builtin_amdgcn_mfma_f32_16x16x32_bf16(Bt[n][k], At[m][k], acc[ai][bj][m][n], 0, 0, 0); } } __builtin_amdgcn_s_setprio(0); } while (0)
#define PG8_MMA0(ai, bj, At, Bt) do { __builtin_amdgcn_s_setprio(1); _Pragma("unroll") for (int m = 0; m < 4; ++m) _Pragma("unroll") for (int n = 0; n < 2; ++n) { \
        if constexpr (FP8) { asm volatile("v_mfma_scale_f32_16x16x128_f8f6f4 %0, %1, %2, 0, %3, %4 op_sel_hi:[0,0,0]" : "=v"(acc[ai][bj][m][n]) : "v"(pg8_cat(Bt[n][0], Bt[n][1])), "v"(pg8_cat(At[m][0], At[m][1])), "v"(vsb), "v"(vsa)); } \
        else { acc[ai][bj][m][n] = __builtin_amdgcn_mfma_f32_16x16x32_bf16(Bt[n][0], At[m][0], (f32x4){0.f, 0.f, 0.f, 0.f}, 0, 0, 0); acc[ai][bj][m][n] = __builtin_amdgcn_mfma_f32_16x16x32_bf16(Bt[n][1], At[m][1], acc[ai][bj][m][n], 0, 0, 0); } } __builtin_amdgcn_s_setprio(0); } while (0)
#define PG8_MMAZ(z, ai, bj, At, Bt) do { if (z) PG8_MMA0(ai, bj, At, Bt); else PG8_MMA(ai, bj, At, Bt); } while (0)
#define PG8_WAIT_V(n) asm volatile("s_waitcnt vmcnt(" #n ")" ::: "memory")
#define PG8_WAIT_L(n) asm volatile("s_waitcnt lgkmcnt(" #n ")" ::: "memory")
#define PG8_BAR __builtin_amdgcn_s_barrier()
#define PG8_SCHED __builtin_amdgcn_sched_barrier(0)
    Unit cur, nxt; int ui = 0;
    if (!S.next(0, cur)) return;
    f32x4 acc[2][2][4][2];
    if constexpr (!(SP2 && FP8 && ZK)) {
#pragma unroll
    for (int a = 0; a < 2; ++a)
#pragma unroll
        for (int b = 0; b < 2; ++b)
#pragma unroll
            for (int m = 0; m < 4; ++m)
#pragma unroll
                for (int n = 0; n < 2; ++n) acc[a][b][m][n] = (f32x4){0.f, 0.f, 0.f, 0.f};
    }
    bf16x8 At[4][2], B0[2][2], B1[2][2];
    typename Epi::Pre pre{};
    int vsa = g.sa, vsb = g.sb; asm volatile("" : "+v"(vsa), "+v"(vsb));
    const char* cA = (const char*)g.A + (size_t)cur.pm * tstepA; const char* cB = (const char*)g.Bt + (size_t)cur.pn * tstepB;
    S.a_ready(cur);
    if constexpr (SP2) {
        PG8_STAGE(PG8_SB(0, 0), cB, voffB); PG8_STAGE(PG8_SB(0, 1), cB + hstepB, voffB); PG8_STAGE(PG8_SA(0, 0), cA, voffA); PG8_STAGE(PG8_SA(0, 1), cA + hstepA, voffA);
        PG8_STAGE(PG8_SB(1, 0), cB + kstep, voffB); PG8_STAGE(PG8_SA(1, 0), cA + kstep, voffA); PG8_STAGE(PG8_SB(1, 1), cB + hstepB + kstep, voffB);
        if (wr == 1) PG8_BAR;
        PG8_WAIT_V(8); PG8_BAR;
        PG8_WAIT_V(6); PG8_BAR;
    } else {
        PG8_STAGE(PG8_SB(0, 0), cB, voffB); PG8_STAGE(PG8_SA(0, 0), cA, voffA); PG8_STAGE(PG8_SB(0, 1), cB + hstepB, voffB); PG8_STAGE(PG8_SA(0, 1), cA + hstepA, voffA);
        if (wr == 1) PG8_BAR;
        PG8_WAIT_V(4); PG8_BAR;
        PG8_STAGE(PG8_SB(1, 0), cB + kstep, voffB); PG8_STAGE(PG8_SA(1, 0), cA + kstep, voffA); PG8_STAGE(PG8_SB(1, 1), cB + hstepB + kstep, voffB);
        PG8_WAIT_V(6); PG8_BAR;
    }
    for (;;) {
        const bool has_next = S.next(ui + 1, nxt);
        const char* nA = has_next ? (const char*)g.A + (size_t)nxt.pm * tstepA : cA; const char* nB = has_next ? (const char*)g.Bt + (size_t)nxt.pn * tstepB : cB;
        for (int t = 0; t < nt; t += 2) {
            if constexpr (Epi::MIDK) { if (t == Epi::MID0 || t == Epi::MID1) E.mid(acc, cur, t, wr, wc, fr, fq); }
            const bool last = (t == nt - 2);
            const char* a1 = cA + (size_t)(t + 1) * kstep;
            const char* a2 = last ? nA : cA + (size_t)(t + 2) * kstep; const char* b2 = last ? nB : cB + (size_t)(t + 2) * kstep;
            const char* a3 = a2 + kstep; const char* b3 = b2 + kstep;
            if (last && has_next) S.a_ready(nxt);
            if (last) pre = E.prefetch(cur, wr, wc, fr, fq);
            if constexpr (SP2) {
            const bool zk = FP8 && ZK && (t == 0);
            PG8_LDB(B0, 0, 0); PG8_LDB(B1, 0, 1); PG8_SCHED; PG8_LDA(At, 0, 0); PG8_STAGE(PG8_SA(1, 1), a1 + hstepA, voffA);
            PG8_WAIT_V(8); PG8_WAIT_L(0); PG8_BAR; PG8_MMAZ(zk, 0, 0, At, B0); PG8_MMAZ(zk, 0, 1, At, B1); PG8_BAR; PG8_SCHED;
            PG8_LDA(At, 0, 1); PG8_STAGE(PG8_SB(0, 0), b2, voffB); PG8_STAGE(PG8_SB(0, 1), b2 + hstepB, voffB); PG8_STAGE(PG8_SA(0, 0), a2, voffA);
            PG8_WAIT_V(8); PG8_WAIT_L(0); PG8_BAR; PG8_MMAZ(zk, 1, 0, At, B0); PG8_MMAZ(zk, 1, 1, At, B1); PG8_BAR; PG8_SCHED;
            PG8_LDB(B0, 1, 0); PG8_LDB(B1, 1, 1); PG8_SCHED; PG8_LDA(At, 1, 0); PG8_STAGE(PG8_SA(0, 1), a2 + hstepA, voffA);
            PG8_WAIT_V(8); PG8_WAIT_L(0); PG8_BAR; PG8_MMA(0, 0, At, B0); PG8_MMA(0, 1, At, B1); PG8_BAR; PG8_SCHED;
            PG8_LDA(At, 1, 1); PG8_STAGE(PG8_SB(1, 0), b3, voffB); PG8_STAGE(PG8_SB(1, 1), b3 + hstepB, voffB); PG8_STAGE(PG8_SA(1, 0), a3, voffA);
            PG8_WAIT_V(8); PG8_WAIT_L(0); PG8_BAR; PG8_MMA(1, 0, At, B0); PG8_MMA(1, 1, At, B1); PG8_BAR; PG8_SCHED;
            } else {
            PG8_LDB(B0, 0, 0); PG8_SCHED; PG8_LDA(At, 0, 0); PG8_STAGE(PG8_SA(1, 1), a1 + hstepA, voffA);
            PG8_WAIT_L(8); PG8_BAR; PG8_WAIT_L(0); PG8_MMA(0, 0, At, B0); PG8_BAR; PG8_SCHED;
            PG8_LDB(B1, 0, 1); PG8_STAGE(PG8_SB(0, 0), b2, voffB);
            PG8_BAR; PG8_WAIT_L(0); PG8_MMA(0, 1, At, B1); PG8_BAR;
            PG8_LDA(At, 0, 1); PG8_STAGE(PG8_SA(0, 0), a2, voffA);
            PG8_BAR; PG8_WAIT_L(0); PG8_MMA(1, 0, At, B0); PG8_BAR; PG8_SCHED;
            PG8_STAGE(PG8_SB(0, 1), b2 + hstepB, voffB);
            PG8_WAIT_V(6); PG8_BAR; PG8_MMA(1, 1, At, B1); PG8_BAR;
            PG8_LDB(B0, 1, 0); PG8_SCHED; PG8_LDA(At, 1, 0); PG8_STAGE(PG8_SA(0, 1), a2 + hstepA, voffA);
            PG8_WAIT_L(8); PG8_BAR; PG8_WAIT_L(0); PG8_MMA(0, 0, At, B0); PG8_BAR; PG8_SCHED;
            PG8_LDB(B1, 1, 1); PG8_STAGE(PG8_SB(1, 0), b3, voffB);
            PG8_BAR; PG8_WAIT_L(0); PG8_MMA(0, 1, At, B1); PG8_BAR;
            PG8_LDA(At, 1, 1); PG8_STAGE(PG8_SA(1, 0), a3, voffA);
            PG8_BAR; PG8_WAIT_L(0); PG8_MMA(1, 0, At, B0); PG8_BAR; PG8_SCHED;
            PG8_STAGE(PG8_SB(1, 1), b3 + hstepB, voffB);
            PG8_WAIT_V(6); PG8_BAR; PG8_MMA(1, 1, At, B1); PG8_BAR;
            }
        }
        if constexpr (ALIGN_EPI) { if (wr == 0) PG8_BAR; }
        if constexpr (FP8) asm volatile("s_nop 15\n\ts_nop 15" ::: "memory");
        if constexpr (!Epi::AFTER_DRAIN) { E(acc, cur, wr, wc, fr, fq, pre); S.done(cur); }
#ifdef PROBE_EPI_TWICE
        if constexpr (!Epi::AFTER_DRAIN) { asm volatile("" ::: "memory"); E(acc, cur, wr, wc, fr, fq, pre); }
#endif
        if (!has_next) break;
        if constexpr (!(SP2 && FP8 && ZK)) {
#pragma unroll
        for (int a = 0; a < 2; ++a)
#pragma unroll
            for (int b = 0; b < 2; ++b)
#pragma unroll
                for (int m = 0; m < 4; ++m)
#pragma unroll
                    for (int n = 0; n < 2; ++n) acc[a][b][m][n] = (f32x4){0.f, 0.f, 0.f, 0.f};
        }
        cur = nxt; cA = nA; cB = nB; ++ui;
        if constexpr (ALIGN_EPI) { if (wr == 1) PG8_BAR; }
    }
    PG8_WAIT_V(0);
    if constexpr (!ALIGN_EPI) { if (wr == 0) PG8_BAR; }
    PG8_BAR;
    if constexpr (Epi::AFTER_DRAIN) { E.fused(acc, cur, wr, wc, fr, fq, lds, wid, lane); S.done(cur); }
#undef PG8_SA
#undef PG8_SB
#undef PG8_STAGE
#undef PG8_LDA
#undef PG8_LDB
#undef PG8_MMA
#undef PG8_MMA0
#undef PG8_MMAZ
#undef PG8_WAIT_V
#undef PG8_WAIT_L
#undef PG8_BAR
#undef PG8_SCHED
}
}
namespace att {
#define ALAS __attribute__((address_space(3)))
typedef unsigned short bf16_t;
using bf16x8 = __attribute__((ext_vector_type(8))) short;
using s16x4 = __attribute__((ext_vector_type(4))) short;
using f32x16 = __attribute__((ext_vector_type(16))) float;
using u32x4 = __attribute__((ext_vector_type(4))) unsigned;
constexpr int S_ = 8192, INW = LD_P, YW = LD_Y;
constexpr int C_DQ = 0, C_DK = 1024, C_DV = 2048, C_SQ = 3072, C_SK = 4096, C_SV = 5120, C_MQ = 6144;
constexpr float LOG2E = 1.4426950408889634f;
constexpr float NEG_BIG = -1e30f;
#define SBAR() __builtin_amdgcn_sched_barrier(0)
__device__ __forceinline__ int crow(int r, int hi) { return (r & 3) + 8 * (r >> 2) + 4 * hi; }
__device__ __forceinline__ unsigned cvtpk(float lo, float hi) { unsigned r; asm volatile("v_cvt_pk_bf16_f32 %0, %1, %2" : "=v"(r) : "v"(lo), "v"(hi)); return r; }
template <int PITCH> __device__ __forceinline__ int kswz(int row, int colB) { return row * PITCH + (colB ^ ((row & 7) << 4)); }
template <int NK, int PITCH>
__device__ __forceinline__ void qkt(f32x16& p0, f32x16& p1, const ALAS char* Ks, const bf16x8* qr, int r32, int hi, int cb0) {
    p0 = f32x16{}; p1 = f32x16{};
#pragma unroll
    for (int d0 = 0; d0 < NK; ++d0) { const int cb = cb0 + (d0 * 16 + hi * 8) * 2;
        const bf16x8 b0 = *(const ALAS bf16x8*)(Ks + kswz<PITCH>(r32, cb)), b1 = *(const ALAS bf16x8*)(Ks + kswz<PITCH>(32 + r32, cb));
        p0 = __builtin_amdgcn_mfma_f32_32x32x16_bf16(b0, qr[d0], p0, 0, 0, 0);
        p1 = __builtin_amdgcn_mfma_f32_32x32x16_bf16(b1, qr[d0], p1, 0, 0, 0); }
}
__device__ __forceinline__ int v_st(int k, int c) { const int kk = (k & ~0xC) | ((k & 4) << 1) | ((k & 8) >> 1); return ((kk >> 3) * 4 + (c >> 5)) * 512 + ((kk & 7) * 32 + (c & 31)) * 2; }
__device__ __forceinline__ int v_rd_base(int lane) { return ((lane & 3) << 3) | (((lane >> 2) & 3) << 6) | (((lane >> 4) & 1) << 5) | (((lane >> 5) & 1) << 8); }
constexpr int v_rd_off(int d0, int ks, int half) { return d0 * 512 + ks * 4096 + half * 2048; }
template <int OFF> __device__ __forceinline__ s16x4 tr_read(int vb) { s16x4 r; asm volatile("ds_read_b64_tr_b16 %0, %1 offset:%2" : "=&v"(r) : "v"(vb), "i"(OFF) : "memory"); return r; }
template <int D0> __device__ __forceinline__ void pv_one(f32x16& od, int vb, bf16x8 pa0, bf16x8 pa1, bf16x8 pa2, bf16x8 pa3) {
    const s16x4 l0 = tr_read<v_rd_off(D0, 0, 0)>(vb), h0 = tr_read<v_rd_off(D0, 0, 1)>(vb), l1 = tr_read<v_rd_off(D0, 1, 0)>(vb), h1 = tr_read<v_rd_off(D0, 1, 1)>(vb);
    const s16x4 l2 = tr_read<v_rd_off(D0, 2, 0)>(vb), h2 = tr_read<v_rd_off(D0, 2, 1)>(vb), l3 = tr_read<v_rd_off(D0, 3, 0)>(vb), h3 = tr_read<v_rd_off(D0, 3, 1)>(vb);
    asm volatile("s_waitcnt lgkmcnt(0)" ::: "memory"); SBAR();
#define PK(L, H) (bf16x8){L[0], L[1], L[2], L[3], H[0], H[1], H[2], H[3]}
    od = __builtin_amdgcn_mfma_f32_32x32x16_bf16(pa0, PK(l0, h0), od, 0, 0, 0);
    od = __builtin_amdgcn_mfma_f32_32x32x16_bf16(pa1, PK(l1, h1), od, 0, 0, 0);
    od = __builtin_amdgcn_mfma_f32_32x32x16_bf16(pa2, PK(l2, h2), od, 0, 0, 0);
    od = __builtin_amdgcn_mfma_f32_32x32x16_bf16(pa3, PK(l3, h3), od, 0, 0, 0);
#undef PK
}
#define PV_RD(L, H, D0) do { L[0] = tr_read<v_rd_off(D0, 0, 0)>(vb); H[0] = tr_read<v_rd_off(D0, 0, 1)>(vb); L[1] = tr_read<v_rd_off(D0, 1, 0)>(vb); H[1] = tr_read<v_rd_off(D0, 1, 1)>(vb); \
        L[2] = tr_read<v_rd_off(D0, 2, 0)>(vb); H[2] = tr_read<v_rd_off(D0, 2, 1)>(vb); L[3] = tr_read<v_rd_off(D0, 3, 0)>(vb); H[3] = tr_read<v_rd_off(D0, 3, 1)>(vb); } while (0)
#define PV_PK(L, H, i) (bf16x8){L[i][0], L[i][1], L[i][2], L[i][3], H[i][0], H[i][1], H[i][2], H[i][3]}
#define PV_MM(od, L, H) do { od = __builtin_amdgcn_mfma_f32_32x32x16_bf16(pa0, PV_PK(L, H, 0), od, 0, 0, 0); od = __builtin_amdgcn_mfma_f32_32x32x16_bf16(pa1, PV_PK(L, H, 1), od, 0, 0, 0); \
        od = __builtin_amdgcn_mfma_f32_32x32x16_bf16(pa2, PV_PK(L, H, 2), od, 0, 0, 0); od = __builtin_amdgcn_mfma_f32_32x32x16_bf16(pa3, PV_PK(L, H, 3), od, 0, 0, 0); } while (0)
__device__ __forceinline__ void pv_d0_pipe(f32x16* o, int vb, bf16x8 pa0, bf16x8 pa1, bf16x8 pa2, bf16x8 pa3) {
    s16x4 la[4], ha[4], lb[4], hb[4];
    PV_RD(la, ha, 0); PV_RD(lb, hb, 1);
    asm volatile("s_waitcnt lgkmcnt(8)" ::: "memory"); SBAR(); PV_MM(o[0], la, ha); SBAR();
    PV_RD(la, ha, 2);
    asm volatile("s_waitcnt lgkmcnt(8)" ::: "memory"); SBAR(); PV_MM(o[1], lb, hb); SBAR();
    PV_RD(lb, hb, 3);
    asm volatile("s_waitcnt lgkmcnt(8)" ::: "memory"); SBAR(); PV_MM(o[2], la, ha); SBAR();
    asm volatile("s_waitcnt lgkmcnt(0)" ::: "memory"); SBAR(); PV_MM(o[3], lb, hb);
}
#undef PV_RD
#undef PV_PK
#undef PV_MM
__device__ __forceinline__ void pv_d0(f32x16* o, int vb, bf16x8 pa0, bf16x8 pa1, bf16x8 pa2, bf16x8 pa3) {
    pv_one<0>(o[0], vb, pa0, pa1, pa2, pa3); pv_one<1>(o[1], vb, pa0, pa1, pa2, pa3); pv_one<2>(o[2], vb, pa0, pa1, pa2, pa3); pv_one<3>(o[3], vb, pa0, pa1, pa2, pa3);
}
__device__ __forceinline__ void pack_p(const f32x16& p0, const f32x16& p1, bf16x8& pa0, bf16x8& pa1, bf16x8& pa2, bf16x8& pa3) {
#define PK4(P, BASE, OUT) do { unsigned a0 = cvtpk(P[BASE + 0], P[BASE + 1]), a1 = cvtpk(P[BASE + 2], P[BASE + 3]);   \
    unsigned b0 = cvtpk(P[BASE + 4], P[BASE + 5]), b1 = cvtpk(P[BASE + 6], P[BASE + 7]);                              \
    auto r0 = __builtin_amdgcn_permlane32_swap(a0, b0, false, false); auto r1 = __builtin_amdgcn_permlane32_swap(a1, b1, false, false); \
    u32x4 w = {r0[0], r1[0], r0[1], r1[1]}; OUT = *reinterpret_cast<bf16x8*>(&w); } while (0)
    PK4(p0, 0, pa0); PK4(p0, 8, pa1); PK4(p1, 0, pa2); PK4(p1, 8, pa3);
#undef PK4
}
__device__ __forceinline__ float swap_max(float v) { auto rr = __builtin_amdgcn_permlane32_swap(__float_as_uint(v), __float_as_uint(v), false, false); return fmaxf(__uint_as_float(rr[0]), __uint_as_float(rr[1])); }
__device__ __forceinline__ float swap_sum(float v) { auto rr = __builtin_amdgcn_permlane32_swap(__float_as_uint(v), __float_as_uint(v), false, false); return __uint_as_float(rr[0]) + __uint_as_float(rr[1]); }
__device__ __forceinline__ float other_half(float v) { auto rr = __builtin_amdgcn_permlane32_swap(__float_as_uint(v), __float_as_uint(v), false, false); return (threadIdx.x & 32) ? __uint_as_float(rr[0]) : __uint_as_float(rr[1]); }

__device__ __forceinline__ int t5_bucket(int n) {
    int b = n < 16 ? n : 16;
    b += (n >= 19) + (n >= 21) + (n >= 24) + (n >= 27) + (n >= 31) + (n >= 35) + (n >= 40) + (n >= 46) + (n >= 52) + (n >= 59) + (n >= 67) + (n >= 77) + (n >= 87) + (n >= 99) + (n >= 113);
    return b;
}
constexpr int L_K = 0, L_V = 32768, L_WS = 49152, L_BT = L_WS + 8 * 256, L_FLAG = L_BT + 512, L_XCH = 65536;
enum { DIFF = 0, SB = 1, MEM = 2 };
struct AttnIO { const bf16_t* proj; const bf16_t* kv; bf16_t* y; const float* rel_bias; const float* subg; float lam; };

template <int MODE>
__device__ __forceinline__ void attn_unit(const AttnIO& io, int b, int h, int qb, int vhalf, ALAS char* lds) {
    constexpr int NK = MODE == DIFF ? 4 : (MODE == SB ? 8 : 16);
    constexpr int KCOLS = MODE == MEM ? 256 : 128, PITCH = KCOLS * 2;
    constexpr int UROWS = MODE == DIFF ? 128 : 256;
    const int tid = threadIdx.x, wid = __builtin_amdgcn_readfirstlane(tid >> 6), lane = tid & 63, r32 = lane & 31, hi = lane >> 5;
    const int rg = MODE == DIFF ? (wid & 3) : wid, map = MODE == DIFF ? (wid >> 2) : 0;
    const int q0 = qb * UROWS, qrow = q0 + rg * 32 + r32;
    const ALAS char* K_lds = lds + L_K; const int vb0 = (int)(unsigned)(uintptr_t)(lds + L_V) + v_rd_base(lane);
    ALAS float* wsf = (ALAS float*)(lds + L_WS) + wid * 64;
    ALAS float* btab = (ALAS float*)(lds + L_BT);
    volatile ALAS int* flags = (volatile ALAS int*)(lds + L_FLAG);
    const bf16_t* Qp; const bf16_t* Kg; const bf16_t* Vg; int ldk;
    if (MODE == DIFF) { Qp = io.proj + ((size_t)b * S_ + qrow) * INW + C_DQ + h * 128 + map * 64; Kg = io.proj + (size_t)b * S_ * INW + C_DK + h * 128; Vg = io.proj + (size_t)b * S_ * INW + C_DV + h * 128; ldk = INW; }
    else if (MODE == SB) { Qp = io.proj + ((size_t)b * S_ + qrow) * INW + C_SQ + h * 128; Kg = io.proj + (size_t)b * S_ * INW + C_SK + h * 128; Vg = io.proj + (size_t)b * S_ * INW + C_SV + h * 128; ldk = INW; }
    else { Qp = io.proj + ((size_t)b * S_ + qrow) * INW + C_MQ + h * 256; Kg = io.kv + (size_t)b * 256 * LD_D + h * 256; Vg = io.kv + (size_t)b * 256 * LD_D + 1024 + h * 256 + vhalf * 128; ldk = LD_D; }
    __syncthreads();
    if (MODE == DIFF && tid < 128) { btab[tid] = io.rel_bias[t5_bucket(tid) * 8 + h] * LOG2E; }
    bf16x8 qr[NK];
    if (MODE == DIFF) {
#pragma unroll
        for (int d0 = 0; d0 < NK; ++d0) qr[d0] = *(const bf16x8*)(Qp + d0 * 16 + hi * 8); }
    const int sr = tid >> 4, sc = (tid & 15) * 8;
    const int vst0 = v_st(sr, sc), vst1 = v_st(32 + sr, sc);
    constexpr int NKB = KCOLS / 128;
    bf16x8 ks0[NKB], ks1[NKB], vs0, vs1;
#define SLOAD(k0) do { _Pragma("unroll") for (int cbk = 0; cbk < NKB; ++cbk) { ks0[cbk] = *(const bf16x8*)(Kg + (size_t)((k0) + sr) * ldk + cbk * 128 + sc); ks1[cbk] = *(const bf16x8*)(Kg + (size_t)((k0) + 32 + sr) * ldk + cbk * 128 + sc); } \
        vs0 = *(const bf16x8*)(Vg + (size_t)((k0) + sr) * ldk + sc); vs1 = *(const bf16x8*)(Vg + (size_t)((k0) + 32 + sr) * ldk + sc); } while (0)
#define SWRITE() do { _Pragma("unroll") for (int cbk = 0; cbk < NKB; ++cbk) { *(ALAS bf16x8*)(lds + L_K + kswz<PITCH>(sr, (cbk * 128 + sc) * 2)) = ks0[cbk]; *(ALAS bf16x8*)(lds + L_K + kswz<PITCH>(32 + sr, (cbk * 128 + sc) * 2)) = ks1[cbk]; } \
        *(ALAS bf16x8*)(lds + L_V + vst0) = vs0; *(ALAS bf16x8*)(lds + L_V + vst1) = vs1; } while (0)
    f32x16 o[4] = {};
    float m_reg = NEG_BIG, l_reg = 0.f, after = 1.f;
    const int NT = MODE == MEM ? 4 : (q0 + UROWS) / 64;
    const float b31 = MODE == DIFF ? io.rel_bias[31 * 8 + h] * LOG2E : 0.f;
    SLOAD(MODE == SB ? (NT - 1) * 64 : 0);
    for (int j = 0; j < NT; ++j) {
        const int kt = MODE == SB ? NT - 1 - j : j, k0 = kt * 64;
        __syncthreads();
        if (MODE == SB && j > 0) { int all = 1;
#pragma unroll
            for (int w = 0; w < 8; ++w) all &= flags[w];
            if (all) break; }
        if (MODE == SB) { const bf16_t* Qpp = Qp; asm volatile("" : "+v"(Qpp));
#pragma unroll
            for (int d0 = 0; d0 < NK; ++d0) qr[d0] = *(const __attribute__((address_space(1))) bf16x8*)(Qpp + d0 * 16 + hi * 8); }
        SWRITE(); if (j + 1 < NT) SLOAD(MODE == SB ? (kt - 1) * 64 : (kt + 1) * 64);
        __syncthreads();
        f32x16 p0, p1;
        if (MODE == MEM) { const bf16_t* Qpp = Qp; asm volatile("" : "+v"(Qpp));
#pragma unroll
            for (int d0 = 0; d0 < NK; ++d0) qr[d0] = *(const __attribute__((address_space(1))) bf16x8*)(Qpp + d0 * 16 + hi * 8); }
        qkt<NK, PITCH>(p0, p1, K_lds, qr, r32, hi, map * 128);
        if (MODE == SB) {
            f32x16 k0v, k1v; float gprod[8], oth[8];
#pragma unroll
            for (int i = 0; i < 8; ++i) { float g = 1.f;
#pragma unroll
                for (int q = 0; q < 4; ++q) { const int r = (i & 3) * 4 + q; const float zl = (i < 4) ? p0[r] : p1[r]; const int key = k0 + q + 8 * (i & 3) + 4 * hi + ((i < 4) ? 0 : 32);
                    const float t = __builtin_amdgcn_exp2f(fminf(zl, 80.f)), kp0 = __builtin_amdgcn_rcpf(1.0f + t);
                    const bool valid = key < qrow; const float kp = valid ? kp0 : 1.0f, sg = valid ? t * kp0 : 0.f;
                    g *= kp; if (i < 4) { k0v[r] = kp; p0[r] = sg; } else { k1v[r] = kp; p1[r] = sg; } }
                gprod[i] = g; }
#pragma unroll
            for (int i = 0; i < 8; ++i) oth[i] = other_half(gprod[i]);
            float Tp = 1.f;
#pragma unroll
            for (int i = 7; i >= 0; --i) { float run = after * Tp * (hi == 0 ? oth[i] : 1.0f);
#pragma unroll
                for (int q = 3; q >= 0; --q) { const int r = (i & 3) * 4 + q;
                    if (i < 4) { p0[r] *= run; run *= k0v[r]; } else { p1[r] *= run; run *= k1v[r]; } }
                Tp *= gprod[i] * oth[i]; }
            after *= Tp;
            if (lane == 0) flags[wid] = 0;
            const int done = __all(after < 1e-37f);
            if (lane == 0) flags[wid] = done;
        } else {
            if (MODE == DIFF) {
                const bool near = (q0 + rg * 32) - (k0 + 63) < 113;
                if (near) {
#pragma unroll
                    for (int r = 0; r < 16; ++r) { const int d0_ = qrow - (k0 + crow(r, hi)), d1_ = d0_ - 32;
                        p0[r] = d0_ < 0 ? NEG_BIG : p0[r] + btab[d0_ < 127 ? d0_ : 127];
                        p1[r] = d1_ < 0 ? NEG_BIG : p1[r] + btab[d1_ < 127 ? d1_ : 127]; }
                } else {
#pragma unroll
                    for (int r = 0; r < 16; ++r) { p0[r] += b31; p1[r] += b31; }
                }
            }
            float pmax = p0[0];
#pragma unroll
            for (int r = 1; r < 16; ++r) pmax = fmaxf(pmax, p0[r]);
#pragma unroll
            for (int r = 0; r < 16; ++r) pmax = fmaxf(pmax, p1[r]);
            pmax = swap_max(pmax);
            const float mn = fmaxf(m_reg, pmax), alpha = __builtin_amdgcn_exp2f(m_reg - mn); m_reg = mn;
            float ps = 0.f;
#pragma unroll
            for (int r = 0; r < 16; ++r) { p0[r] = __builtin_amdgcn_exp2f(p0[r] - mn); p1[r] = __builtin_amdgcn_exp2f(p1[r] - mn); ps += p0[r] + p1[r]; }
            ps = swap_sum(ps);
            l_reg = l_reg * alpha + ps;
            if (__any(alpha < 1.0f)) { if (hi == 0) wsf[r32] = alpha; asm volatile("s_waitcnt lgkmcnt(0)" ::: "memory");
#pragma unroll
                for (int d = 0; d < 4; ++d)
#pragma unroll
                    for (int r = 0; r < 16; ++r) o[d][r] *= wsf[crow(r, hi)]; }
        }
        bf16x8 pa0, pa1, pa2, pa3;
        pack_p(p0, p1, pa0, pa1, pa2, pa3);
        SBAR();
        pv_d0_pipe(o, vb0, pa0, pa1, pa2, pa3);
    }
    float rl[16];
    if (MODE != SB) { if (hi == 0) wsf[32 + r32] = l_reg; asm volatile("s_waitcnt lgkmcnt(0)" ::: "memory");
#pragma unroll
        for (int r = 0; r < 16; ++r) rl[r] = __builtin_amdgcn_rcpf(wsf[32 + crow(r, hi)]); }
    else {
#pragma unroll
        for (int r = 0; r < 16; ++r) rl[r] = 1.0f; }
    if (MODE == DIFF) {
        ALAS float* xch = (ALAS float*)(lds + L_XCH) + rg * 4096;
        if (map == 1) {
#pragma unroll
            for (int d = 0; d < 4; ++d)
#pragma unroll
                for (int r = 0; r < 16; ++r) xch[(d * 16 + r) * 64 + lane] = o[d][r] * rl[r]; }
        __syncthreads();
        if (map == 0) {
            float ss[16];
#pragma unroll
            for (int r = 0; r < 16; ++r) { float s = 0.f;
#pragma unroll
                for (int d = 0; d < 4; ++d) { const float yv = o[d][r] * rl[r] - io.lam * xch[(d * 16 + r) * 64 + lane]; o[d][r] = yv; s += yv * yv; }
                ss[r] = s; }
#pragma unroll
            for (int r = 0; r < 16; ++r) {
#pragma unroll
                for (int off = 1; off < 32; off <<= 1) ss[r] += __shfl_xor(ss[r], off); }
            float sg[4];
#pragma unroll
            for (int d = 0; d < 4; ++d) sg[d] = io.subg[d * 32 + r32] * 0.8f;
#pragma unroll
            for (int r = 0; r < 16; ++r) { const float rs = rsqrtf(ss[r] * (1.0f / 128.0f) + 1e-6f);
                bf16_t* yp = io.y + ((size_t)b * S_ + q0 + rg * 32 + crow(r, hi)) * YW + h * 128 + r32;
#pragma unroll
                for (int d = 0; d < 4; ++d) yp[d * 32] = (bf16_t)(cvtpk(o[d][r] * rs * sg[d], 0.f) & 0xffffu); }
        }
    } else {
        const int ycol = MODE == SB ? 1024 + h * 128 : 2048 + h * 256 + vhalf * 128;
#pragma unroll
        for (int r = 0; r < 16; ++r) { bf16_t* yp = io.y + ((size_t)b * S_ + q0 + rg * 32 + crow(r, hi)) * YW + ycol + r32;
#pragma unroll
            for (int d = 0; d < 4; ++d) yp[d * 32] = (bf16_t)(cvtpk(o[d][r] * rl[r], 0.f) & 0xffffu); }
    }
#undef SLOAD
#undef SWRITE
}

constexpr int D2_SLOT = 32768, D2_WS = 131072 + 2048, D2_BT = D2_WS + 2048;
constexpr float THR2 = 6.0f;
__device__ __forceinline__ void attn_unit_diff2(const AttnIO& io, int b, int h, int qb, ALAS char* lds) {
    const int tid = threadIdx.x, wid = __builtin_amdgcn_readfirstlane(tid >> 6), lane = tid & 63, r32 = lane & 31, hi = lane >> 5;
    const int rg = wid & 3, map = wid >> 2, q0 = qb * 128, qrow = q0 + rg * 32 + r32;
    ALAS float* wsf = (ALAS float*)(lds + D2_WS) + wid * 64;
    ALAS float* dtab = (ALAS float*)(lds + D2_BT);
    const bf16_t* Qp = io.proj + ((size_t)b * S_ + qrow) * INW + C_DQ + h * 128 + map * 64;
    const bf16_t* Kg = io.proj + (size_t)b * S_ * INW + C_DK + h * 128; const bf16_t* Vg = io.proj + (size_t)b * S_ * INW + C_DV + h * 128;
    const float b31 = io.rel_bias[31 * 8 + h] * LOG2E;
    __syncthreads();
    if (tid < 128) dtab[tid] = io.rel_bias[t5_bucket(tid) * 8 + h] * LOG2E - b31;
    unsigned koff[2], voff[2];
#pragma unroll
    for (int i = 0; i < 2; ++i) { const int p = 2 * wid + i, row = 4 * p + (lane >> 4), c = (lane & 15) ^ (row & 7); koff[i] = (unsigned)(row * INW + c * 8);
        const int st = 2 * p + (lane >> 5), kk = (st >> 2) * 8 + ((lane & 31) >> 2), k = (kk & ~0xC) | ((kk & 4) << 1) | ((kk & 8) >> 1), col = (st & 3) * 32 + (lane & 3) * 8; voff[i] = (unsigned)(k * INW + col); }
    const int NT = (q0 + 128) / 64;
#define D2_ISSUE(t) do { const int sl_ = ((t) & 3) * D2_SLOT; const bf16_t* kb_ = Kg + (size_t)(t) * 64 * INW; const bf16_t* vb_ = Vg + (size_t)(t) * 64 * INW; \
        _Pragma("unroll") for (int i_ = 0; i_ < 2; ++i_) { \
            __builtin_amdgcn_global_load_lds((const unsigned*)(kb_ + koff[i_]), (ALAS unsigned*)(lds + sl_ + (2 * wid + i_) * 1024), 16, 0, 0); \
            __builtin_amdgcn_global_load_lds((const unsigned*)(vb_ + voff[i_]), (ALAS unsigned*)(lds + sl_ + 16384 + (2 * wid + i_) * 1024), 16, 0, 0); } } while (0)
    D2_ISSUE(0); D2_ISSUE(1);
    bf16x8 qr[4];
#pragma unroll
    for (int d0 = 0; d0 < 4; ++d0) qr[d0] = *(const bf16x8*)(Qp + d0 * 16 + hi * 8);
    f32x16 o[4] = {}; f32x16 negm;
#pragma unroll
    for (int r = 0; r < 16; ++r) negm[r] = b31;
    float mref = 0.f, l_reg = 0.f;
    const int vbase = (int)(unsigned)(uintptr_t)(lds + 16384) + v_rd_base(lane);
    bf16x8 pa0 = {}, pa1 = {}, pa2 = {}, pa3 = {};
    for (int j = 0; j < NT; ++j) {
        if (j + 1 < NT) asm volatile("s_waitcnt vmcnt(4)" ::: "memory"); else asm volatile("s_waitcnt vmcnt(0)" ::: "memory");
        __builtin_amdgcn_s_barrier(); asm volatile("" ::: "memory");
        if (map == 1 && j > 0) pv_d0_pipe(o, vbase + ((j - 1) & 3) * D2_SLOT, pa0, pa1, pa2, pa3);
        const int k0 = j * 64; const ALAS char* Ks = lds + (j & 3) * D2_SLOT;
        f32x16 p0, p1;
#define D2_SCORES() do { \
        _Pragma("unroll") for (int d0 = 0; d0 < 4; ++d0) { const int cb = map * 128 + (d0 * 16 + hi * 8) * 2; \
            const bf16x8 kb0 = *(const ALAS bf16x8*)(Ks + kswz<256>(r32, cb)), kb1 = *(const ALAS bf16x8*)(Ks + kswz<256>(32 + r32, cb)); \
            if (d0 == 0) { p0 = __builtin_amdgcn_mfma_f32_32x32x16_bf16(kb0, qr[0], negm, 0, 0, 0); p1 = __builtin_amdgcn_mfma_f32_32x32x16_bf16(kb1, qr[0], negm, 0, 0, 0); } \
            else { p0 = __builtin_amdgcn_mfma_f32_32x32x16_bf16(kb0, qr[d0], p0, 0, 0, 0); p1 = __builtin_amdgcn_mfma_f32_32x32x16_bf16(kb1, qr[d0], p1, 0, 0, 0); } } \
        if ((q0 + rg * 32) - (k0 + 63) < 113) { \
            _Pragma("unroll") for (int r = 0; r < 16; ++r) { const int d0_ = qrow - (k0 + crow(r, hi)), d1_ = d0_ - 32; \
                const float t0 = dtab[d0_ < 0 ? 0 : (d0_ < 127 ? d0_ : 127)], t1 = dtab[d1_ < 0 ? 0 : (d1_ < 127 ? d1_ : 127)]; \
                p0[r] = d0_ < 0 ? NEG_BIG : p0[r] + t0; p1[r] = d1_ < 0 ? NEG_BIG : p1[r] + t1; } } } while (0)
#define D2_REBASE() do { \
        float mx0 = fmaxf(fmaxf(p0[0], p0[1]), p0[2]), mx1 = fmaxf(fmaxf(p0[3], p0[4]), p0[5]), mx2 = fmaxf(fmaxf(p1[0], p1[1]), p1[2]), mx3 = fmaxf(fmaxf(p1[3], p1[4]), p1[5]); \
        mx0 = fmaxf(fmaxf(mx0, p0[6]), p0[7]); mx1 = fmaxf(fmaxf(mx1, p0[8]), p0[9]); mx2 = fmaxf(fmaxf(mx2, p1[6]), p1[7]); mx3 = fmaxf(fmaxf(mx3, p1[8]), p1[9]); \
        mx0 = fmaxf(fmaxf(mx0, p0[10]), p0[11]); mx1 = fmaxf(fmaxf(mx1, p0[12]), p0[13]); mx2 = fmaxf(fmaxf(mx2, p1[10]), p1[11]); mx3 = fmaxf(fmaxf(mx3, p1[12]), p1[13]); \
        mx0 = fmaxf(fmaxf(mx0, p0[14]), p0[15]); mx2 = fmaxf(fmaxf(mx2, p1[14]), p1[15]); \
        const float pmax = swap_max(fmaxf(fmaxf(mx0, mx1), fmaxf(mx2, mx3))); \
        const float dl = (j == 0) ? pmax : fmaxf(pmax, 0.f); mref += dl; \
        _Pragma("unroll") for (int r = 0; r < 16; ++r) { p0[r] -= dl; p1[r] -= dl; negm[r] -= dl; } \
        const float alpha = __builtin_amdgcn_exp2f(-dl); l_reg *= alpha; \
        if (j > 0) { if (hi == 0) wsf[r32] = alpha; asm volatile("s_waitcnt lgkmcnt(0)" ::: "memory"); \
            _Pragma("unroll") for (int d = 0; d < 4; ++d) _Pragma("unroll") for (int r = 0; r < 16; ++r) o[d][r] *= wsf[crow(r, hi)]; } } while (0)
#define D2_EXPSUM(PS) do { \
        _Pragma("unroll") for (int r = 0; r < 16; ++r) { p0[r] = __builtin_amdgcn_exp2f(p0[r]); p1[r] = __builtin_amdgcn_exp2f(p1[r]); } \
        float ps0 = p0[0] + p1[0], ps1 = p0[1] + p1[1], ps2 = p0[2] + p1[2], ps3 = p0[3] + p1[3]; \
        _Pragma("unroll") for (int r = 4; r < 16; r += 4) { ps0 += p0[r] + p1[r]; ps1 += p0[r + 1] + p1[r + 1]; ps2 += p0[r + 2] + p1[r + 2]; ps3 += p0[r + 3] + p1[r + 3]; } \
        PS = swap_sum((ps0 + ps1) + (ps2 + ps3)); } while (0)
        D2_SCORES();
        if (j == 0) D2_REBASE();
        float ps_row;
        D2_EXPSUM(ps_row);
        if (j > 0 && __any(!(ps_row < 8192.0f))) { D2_SCORES(); D2_REBASE(); D2_EXPSUM(ps_row); }
        l_reg += ps_row;
#undef D2_SCORES
#undef D2_REBASE
#undef D2_EXPSUM
        asm volatile("" ::: "memory");
        if (j + 2 < NT) D2_ISSUE(j + 2);
        asm volatile("" ::: "memory");
        pack_p(p0, p1, pa0, pa1, pa2, pa3);
        SBAR();
        if (map == 0) pv_d0_pipe(o, vbase + (j & 3) * D2_SLOT, pa0, pa1, pa2, pa3);
    }
    if (map == 1) pv_d0_pipe(o, vbase + ((NT - 1) & 3) * D2_SLOT, pa0, pa1, pa2, pa3);
#undef D2_ISSUE
    if (hi == 0) wsf[32 + r32] = l_reg; asm volatile("s_waitcnt lgkmcnt(0)" ::: "memory");
    float rl[16];
#pragma unroll
    for (int r = 0; r < 16; ++r) rl[r] = __builtin_amdgcn_rcpf(wsf[32 + crow(r, hi)]);
    __syncthreads();
    ALAS float* xch = (ALAS float*)lds + rg * 4096;
    if (map == 1) {
#pragma unroll
        for (int d = 0; d < 4; ++d)
#pragma unroll
            for (int r = 0; r < 16; ++r) xch[(d * 16 + r) * 64 + lane] = o[d][r] * rl[r]; }
    __syncthreads();
    if (map == 0) {
        float ss[16];
#pragma unroll
        for (int r = 0; r < 16; ++r) { float s = 0.f;
#pragma unroll
            for (int d = 0; d < 4; ++d) { const float yv = o[d][r] * rl[r] - io.lam * xch[(d * 16 + r) * 64 + lane]; o[d][r] = yv; s += yv * yv; }
            ss[r] = s; }
#pragma unroll
        for (int r = 0; r < 16; ++r) {
#pragma unroll
            for (int off = 1; off < 32; off <<= 1) ss[r] += __shfl_xor(ss[r], off); }
        float sg[4];
#pragma unroll
        for (int d = 0; d < 4; ++d) sg[d] = io.subg[d * 32 + r32] * 0.8f;
#pragma unroll
        for (int r = 0; r < 16; ++r) { const float rs = rsqrtf(ss[r] * (1.0f / 128.0f) + 1e-6f);
            bf16_t* yp = io.y + ((size_t)b * S_ + q0 + rg * 32 + crow(r, hi)) * YW + h * 128 + r32;
#pragma unroll
            for (int d = 0; d < 4; ++d) yp[d * 32] = (bf16_t)(cvtpk(o[d][r] * rs * sg[d], 0.f) & 0xffffu); }
    }
}

struct CvCtx { const float* w1; const float* w2; unsigned char* d1; unsigned char* d2; float sc; };
constexpr int CV_TOTAL = 32 * 64 * 128 + 32 * 64 * 64;
constexpr int D3_STG = 98304;
__device__ __forceinline__ int cv_unit_items(int qb) { return 8 * (2 * (qb + 1) - ((qb + 1) >> 1)); }
__device__ __forceinline__ int cv_unit_base(int bh, int qb) { return bh * (8 * 3136) + 8 * (qb * (qb + 1) - ((qb * qb) >> 2)); }
__device__ __forceinline__ void cv_decode(const CvCtx& cv, int g, const float*& src, int& N, unsigned char*& dst) {
    if (g < 32 * 64 * 128) { const int e = g >> 13, r = g & 8191, nb = r >> 6, kb = r & 63, n0 = nb * 32, k0 = kb * 32;
        const int nn = n0 & 2047, drow = (nn >> 7) * 256 + (n0 >= 2048 ? 128 : 0) + (nn & 127);
        src = cv.w1 + (size_t)e * 2048 * 4096 + (size_t)k0 * 4096 + n0; N = 4096; dst = cv.d1 + ((size_t)e * 4096 + drow) * LD_F8 + k0; }
    else { const int g2 = g - 32 * 64 * 128, e = g2 >> 12, r = g2 & 4095, nb = r >> 6, kb = r & 63, n0 = nb * 32, k0 = kb * 32;
        src = cv.w2 + (size_t)e * 2048 * 2048 + (size_t)k0 * 2048 + n0; N = 2048; dst = cv.d2 + ((size_t)e * 2048 + n0) * LD_F8 + k0; }
}
__device__ __forceinline__ void cv_issue(const float* src, int N, ALAS char* stg, int lane) {
#pragma unroll
    for (int q = 0; q < 4; ++q) { const int kr = 8 * q + (lane >> 3), c4 = (lane & 7) ^ (kr & 7);
        __builtin_amdgcn_global_load_lds((const unsigned*)(src + (size_t)kr * N + 4 * c4), (ALAS unsigned*)(stg + q * 1024), 16, 0, 2); }
}
__device__ __forceinline__ unsigned pk4_fp8_att(float a, float b, float c, float d) {
    a = __builtin_amdgcn_fmed3f(a, -448.f, 448.f); b = __builtin_amdgcn_fmed3f(b, -448.f, 448.f); c = __builtin_amdgcn_fmed3f(c, -448.f, 448.f); d = __builtin_amdgcn_fmed3f(d, -448.f, 448.f);
    int w = 0; w = __builtin_amdgcn_cvt_pk_fp8_f32(a, b, w, false); w = __builtin_amdgcn_cvt_pk_fp8_f32(c, d, w, true); return (unsigned)w;
}
#define VM_WAIT_LE(n) do { if ((n) >= 8) asm volatile("s_waitcnt vmcnt(8)" ::: "memory"); else if ((n) >= 4) asm volatile("s_waitcnt vmcnt(4)" ::: "memory"); else asm volatile("s_waitcnt vmcnt(0)" ::: "memory"); } while (0)
__device__ __forceinline__ void attn_unit_diff3(const AttnIO& io, const CvCtx& cv, int b, int h, int qb, ALAS char* lds) {
    const int tid = threadIdx.x, wid = __builtin_amdgcn_readfirstlane(tid >> 6), lane = tid & 63, r32 = lane & 31, hi = lane >> 5;
    const int rg = wid & 3, map = wid >> 2, q0 = qb * 128, qrow = q0 + rg * 32 + r32;
    ALAS float* wsf = (ALAS float*)(lds + D2_WS) + wid * 64;
    ALAS float* dtab = (ALAS float*)(lds + D2_BT);
    ALAS char* stg = lds + D3_STG + wid * 4096;
    const bf16_t* Qp = io.proj + ((size_t)b * S_ + qrow) * INW + C_DQ + h * 128 + map * 64;
    const bf16_t* Kg = io.proj + (size_t)b * S_ * INW + C_DK + h * 128; const bf16_t* Vg = io.proj + (size_t)b * S_ * INW + C_DV + h * 128;
    const float b31 = io.rel_bias[31 * 8 + h] * LOG2E;
    const int NT = (q0 + 128) / 64;
    const int per = cv_unit_items(qb) >> 3; int it0 = cv_unit_base(b * 8 + h, qb) + wid * per; int nit = CV_TOTAL - it0; nit = nit < 0 ? 0 : (nit > per ? per : nit);
    __syncthreads();
    if (tid < 128) dtab[tid] = io.rel_bias[t5_bucket(tid) * 8 + h] * LOG2E - b31;
    unsigned koff[2], voff[2];
#pragma unroll
    for (int i = 0; i < 2; ++i) { const int p = 2 * wid + i, row = 4 * p + (lane >> 4), c = (lane & 15) ^ (row & 7); koff[i] = (unsigned)(row * INW + c * 8);
        const int st = 2 * p + (lane >> 5), kk = (st >> 2) * 8 + ((lane & 31) >> 2), k = (kk & ~0xC) | ((kk & 4) << 1) | ((kk & 8) >> 1), col = (st & 3) * 32 + (lane & 3) * 8; voff[i] = (unsigned)(k * INW + col); }
    int sl_j = 0, sl_n = 2 * D2_SLOT;
#define D3_ISSUE(t, sl_) do { const bf16_t* kb_ = Kg + (size_t)(t) * 64 * INW; const bf16_t* vb_ = Vg + (size_t)(t) * 64 * INW; \
        _Pragma("unroll") for (int i_ = 0; i_ < 2; ++i_) { \
            __builtin_amdgcn_global_load_lds((const unsigned*)(kb_ + koff[i_]), (ALAS unsigned*)(lds + (sl_) + (2 * wid + i_) * 1024), 16, 0, 0); \
            __builtin_amdgcn_global_load_lds((const unsigned*)(vb_ + voff[i_]), (ALAS unsigned*)(lds + (sl_) + 16384 + (2 * wid + i_) * 1024), 16, 0, 0); } } while (0)
    int sk0, sk1, sd = 0, cr = 0;
    D3_ISSUE(0, 0); D3_ISSUE(1, D2_SLOT); sk0 = 4; sk1 = 0;
    if (nit > 0) { const float* src; int N; unsigned char* dst; cv_decode(cv, it0, src, N, dst); cv_issue(src, N, stg, lane); sk0 += 4; sk1 += 4; sd = 0; }
    asm volatile("" ::: "memory");
    bf16x8 qr[4];
#pragma unroll
    for (int d0 = 0; d0 < 4; ++d0) qr[d0] = *(const bf16x8*)(Qp + d0 * 16 + hi * 8);
    f32x16 o[4] = {}; f32x16 negm;
#pragma unroll
    for (int r = 0; r < 16; ++r) negm[r] = b31;
    float mref = 0.f, l_reg = 0.f;
    const int vbase = (int)(unsigned)(uintptr_t)(lds + 16384) + v_rd_base(lane);
    for (int j = 0; j < NT; ++j) {
        const bool cvt = ((j & 3) != 3) && cr < nit;
        { const int allow = cvt ? (sk0 < sd ? sk0 : sd) : sk0; VM_WAIT_LE(allow); }
        __builtin_amdgcn_s_barrier(); asm volatile("" ::: "memory");
        if (cvt) {
            const float* src; int N; unsigned char* dst; cv_decode(cv, it0 + cr, src, N, dst);
            const int n = lane & 31, kh = lane >> 5; const ALAS float* sp = (const ALAS float*)stg;
            float v[16];
#pragma unroll
            for (int i = 0; i < 16; ++i) { const int k = 16 * kh + i; v[i] = sp[k * 32 + ((((n >> 2) ^ (k & 7)) << 2) | (n & 3))]; }
            asm volatile("s_waitcnt lgkmcnt(0)" ::: "memory");
            if (cr + 1 < nit) { const float* s2; int N2; unsigned char* d2; cv_decode(cv, it0 + cr + 1, s2, N2, d2); cv_issue(s2, N2, stg, lane); sk0 += 4; sk1 += 4; sd = 0; }
            asm volatile("" ::: "memory");
            u32x4 w; const float sc = cv.sc;
            w.x = pk4_fp8_att(v[0] * sc, v[1] * sc, v[2] * sc, v[3] * sc); w.y = pk4_fp8_att(v[4] * sc, v[5] * sc, v[6] * sc, v[7] * sc);
            w.z = pk4_fp8_att(v[8] * sc, v[9] * sc, v[10] * sc, v[11] * sc); w.w = pk4_fp8_att(v[12] * sc, v[13] * sc, v[14] * sc, v[15] * sc);
            *(__attribute__((address_space(1))) u32x4*)(dst + (size_t)n * LD_F8 + 16 * kh) = w;
            asm volatile("" ::: "memory");
            ++cr;
        }
        if (j + 2 < NT) { D3_ISSUE(j + 2, sl_n); sd += 4; sk0 = sk1 + 4; sk1 = 0; } else { sk0 = sk1; sk1 = 0; }
        asm volatile("" ::: "memory");
        const int k0 = j * 64; const ALAS char* Ks = lds + sl_j;
        f32x16 p0, p1;
#pragma unroll
        for (int d0 = 0; d0 < 4; ++d0) { const int cb = map * 128 + (d0 * 16 + hi * 8) * 2;
            const bf16x8 kb0 = *(const ALAS bf16x8*)(Ks + kswz<256>(r32, cb)), kb1 = *(const ALAS bf16x8*)(Ks + kswz<256>(32 + r32, cb));
            if (d0 == 0) { p0 = __builtin_amdgcn_mfma_f32_32x32x16_bf16(kb0, qr[0], negm, 0, 0, 0); p1 = __builtin_amdgcn_mfma_f32_32x32x16_bf16(kb1, qr[0], negm, 0, 0, 0); }
            else { p0 = __builtin_amdgcn_mfma_f32_32x32x16_bf16(kb0, qr[d0], p0, 0, 0, 0); p1 = __builtin_amdgcn_mfma_f32_32x32x16_bf16(kb1, qr[d0], p1, 0, 0, 0); } }
        if ((q0 + rg * 32) - (k0 + 63) < 113) {
#pragma unroll
            for (int r = 0; r < 16; ++r) { const int d0_ = qrow - (k0 + crow(r, hi)), d1_ = d0_ - 32;
                const float t0 = dtab[d0_ < 0 ? 0 : (d0_ < 127 ? d0_ : 127)], t1 = dtab[d1_ < 0 ? 0 : (d1_ < 127 ? d1_ : 127)];
                p0[r] = d0_ < 0 ? NEG_BIG : p0[r] + t0; p1[r] = d1_ < 0 ? NEG_BIG : p1[r] + t1; } }
        float mx0 = fmaxf(fmaxf(p0[0], p0[1]), p0[2]), mx1 = fmaxf(fmaxf(p0[3], p0[4]), p0[5]), mx2 = fmaxf(fmaxf(p1[0], p1[1]), p1[2]), mx3 = fmaxf(fmaxf(p1[3], p1[4]), p1[5]);
        mx0 = fmaxf(fmaxf(mx0, p0[6]), p0[7]); mx1 = fmaxf(fmaxf(mx1, p0[8]), p0[9]); mx2 = fmaxf(fmaxf(mx2, p1[6]), p1[7]); mx3 = fmaxf(fmaxf(mx3, p1[8]), p1[9]);
        mx0 = fmaxf(fmaxf(mx0, p0[10]), p0[11]); mx1 = fmaxf(fmaxf(mx1, p0[12]), p0[13]); mx2 = fmaxf(fmaxf(mx2, p1[10]), p1[11]); mx3 = fmaxf(fmaxf(mx3, p1[12]), p1[13]);
        mx0 = fmaxf(fmaxf(mx0, p0[14]), p0[15]); mx2 = fmaxf(fmaxf(mx2, p1[14]), p1[15]);
        float pmax = swap_max(fmaxf(fmaxf(mx0, mx1), fmaxf(mx2, mx3)));
        if (j == 0 || __any(pmax > THR2)) {
            const float dl = (j == 0) ? pmax : fmaxf(pmax, 0.f); mref += dl;
#pragma unroll
            for (int r = 0; r < 16; ++r) { p0[r] -= dl; p1[r] -= dl; negm[r] -= dl; }
            const float alpha = __builtin_amdgcn_exp2f(-dl); l_reg *= alpha;
            if (j > 0) { if (hi == 0) wsf[r32] = alpha; asm volatile("s_waitcnt lgkmcnt(0)" ::: "memory");
#pragma unroll
                for (int d = 0; d < 4; ++d)
#pragma unroll
                    for (int r = 0; r < 16; ++r) o[d][r] *= wsf[crow(r, hi)]; } }
#pragma unroll
        for (int r = 0; r < 16; ++r) { p0[r] = __builtin_amdgcn_exp2f(p0[r]); p1[r] = __builtin_amdgcn_exp2f(p1[r]); }
        float ps0 = p0[0] + p1[0], ps1 = p0[1] + p1[1], ps2 = p0[2] + p1[2], ps3 = p0[3] + p1[3];
#pragma unroll
        for (int r = 4; r < 16; r += 4) { ps0 += p0[r] + p1[r]; ps1 += p0[r + 1] + p1[r + 1]; ps2 += p0[r + 2] + p1[r + 2]; ps3 += p0[r + 3] + p1[r + 3]; }
        l_reg += swap_sum((ps0 + ps1) + (ps2 + ps3));
        bf16x8 pa0, pa1, pa2, pa3;
        pack_p(p0, p1, pa0, pa1, pa2, pa3);
        SBAR();
        pv_d0_pipe(o, vbase + sl_j, pa0, pa1, pa2, pa3);
        sl_j = (sl_j == 2 * D2_SLOT) ? 0 : sl_j + D2_SLOT; sl_n = (sl_n == 2 * D2_SLOT) ? 0 : sl_n + D2_SLOT;
    }
#undef D3_ISSUE
    while (cr < nit) {
        asm volatile("s_waitcnt vmcnt(0)" ::: "memory");
        const float* src; int N; unsigned char* dst; cv_decode(cv, it0 + cr, src, N, dst);
        const int n = lane & 31, kh = lane >> 5; const ALAS float* sp = (const ALAS float*)stg;
        float v[16];
#pragma unroll
        for (int i = 0; i < 16; ++i) { const int k = 16 * kh + i; v[i] = sp[k * 32 + ((((n >> 2) ^ (k & 7)) << 2) | (n & 3))]; }
        asm volatile("s_waitcnt lgkmcnt(0)" ::: "memory");
        if (cr + 1 < nit) { const float* s2; int N2; unsigned char* d2; cv_decode(cv, it0 + cr + 1, s2, N2, d2); cv_issue(s2, N2, stg, lane); }
        asm volatile("" ::: "memory");
        u32x4 w; const float sc = cv.sc;
        w.x = pk4_fp8_att(v[0] * sc, v[1] * sc, v[2] * sc, v[3] * sc); w.y = pk4_fp8_att(v[4] * sc, v[5] * sc, v[6] * sc, v[7] * sc);
        w.z = pk4_fp8_att(v[8] * sc, v[9] * sc, v[10] * sc, v[11] * sc); w.w = pk4_fp8_att(v[12] * sc, v[13] * sc, v[14] * sc, v[15] * sc);
        *(__attribute__((address_space(1))) u32x4*)(dst + (size_t)n * LD_F8 + 16 * kh) = w;
        ++cr;
    }
    if (hi == 0) wsf[32 + r32] = l_reg; asm volatile("s_waitcnt lgkmcnt(0)" ::: "memory");
    float rl[16];
#pragma unroll
    for (int r = 0; r < 16; ++r) rl[r] = __builtin_amdgcn_rcpf(wsf[32 + crow(r, hi)]);
    asm volatile("s_waitcnt vmcnt(0)" ::: "memory");
    __syncthreads();
    ALAS float* xch = (ALAS float*)lds + rg * 4096;
    if (map == 1) {
#pragma unroll
        for (int d = 0; d < 4; ++d)
#pragma unroll
            for (int r = 0; r < 16; ++r) xch[(d * 16 + r) * 64 + lane] = o[d][r] * rl[r]; }
    __syncthreads();
    if (map == 0) {
        float ss[16];
#pragma unroll
        for (int r = 0; r < 16; ++r) { float s = 0.f;
#pragma unroll
            for (int d = 0; d < 4; ++d) { const float yv = o[d][r] * rl[r] - io.lam * xch[(d * 16 + r) * 64 + lane]; o[d][r] = yv; s += yv * yv; }
            ss[r] = s; }
#pragma unroll
        for (int r = 0; r < 16; ++r) {
#pragma unroll
            for (int off = 1; off < 32; off <<= 1) ss[r] += __shfl_xor(ss[r], off); }
        float sg[4];
#pragma unroll
        for (int d = 0; d < 4; ++d) sg[d] = io.subg[d * 32 + r32] * 0.8f;
#pragma unroll
        for (int r = 0; r < 16; ++r) { const float rs = rsqrtf(ss[r] * (1.0f / 128.0f) + 1e-6f);
            bf16_t* yp = io.y + ((size_t)b * S_ + q0 + rg * 32 + crow(r, hi)) * YW + h * 128 + r32;
#pragma unroll
            for (int d = 0; d < 4; ++d) yp[d * 32] = (bf16_t)(cvtpk(o[d][r] * rs * sg[d], 0.f) & 0xffffu); }
    }
}
#undef VM_WAIT_LE
constexpr int CV4_TOTAL = 32 * 128 * 128;
__device__ __forceinline__ int cv4_unit_base(int bh, int qb) { return bh * (8 * 4160) + 8 * qb * (qb + 1); }
__device__ __forceinline__ void cv4_decode(const CvCtx& cv, int g, const float*& src, unsigned char*& dst) {
    const int e = g >> 14, r = g & 16383, nb = r >> 7, kb = r & 127, n0 = nb * 32, k0 = kb * 16;
    const int nn = n0 & 2047, drow = (nn >> 7) * 256 + (n0 >= 2048 ? 128 : 0) + (nn & 127);
    src = cv.w1 + (size_t)e * 2048 * 4096 + (size_t)k0 * 4096 + n0; dst = cv.d1 + ((size_t)e * 4096 + drow) * LD_F8 + k0;
}
__device__ __forceinline__ void cv4_issue(const float* src, ALAS char* stg, int lane) {
#pragma unroll
    for (int q = 0; q < 2; ++q) { const int kr = 8 * q + (lane >> 3), c4 = (lane & 7) ^ (kr & 7);
        __builtin_amdgcn_global_load_lds((const unsigned*)(src + (size_t)kr * 4096 + 4 * c4), (ALAS unsigned*)(stg + q * 1024), 16, 0, 2); }
}
#define VM_WAIT_LE(n) do { if ((n) >= 10) asm volatile("s_waitcnt vmcnt(10)" ::: "memory"); else if ((n) >= 8) asm volatile("s_waitcnt vmcnt(8)" ::: "memory"); else if ((n) >= 6) asm volatile("s_waitcnt vmcnt(6)" ::: "memory"); \
    else if ((n) >= 4) asm volatile("s_waitcnt vmcnt(4)" ::: "memory"); else if ((n) >= 2) asm volatile("s_waitcnt vmcnt(2)" ::: "memory"); else asm volatile("s_waitcnt vmcnt(0)" ::: "memory"); } while (0)
__device__ __forceinline__ void attn_unit_diff4(const AttnIO& io, const CvCtx& cv, int b, int h, int qb, ALAS char* lds) {
    const int tid = threadIdx.x, wid = __builtin_amdgcn_readfirstlane(tid >> 6), lane = tid & 63, r32 = lane & 31, hi = lane >> 5;
    const int rg = wid & 3, map = wid >> 2, q0 = qb * 128, qrow = q0 + rg * 32 + r32;
    ALAS float* wsf = (ALAS float*)(lds + D2_WS) + wid * 64;
    ALAS float* dtab = (ALAS float*)(lds + D2_BT);
    ALAS char* stg = lds + 98304 + wid * 4096;
    const bf16_t* Qp = io.proj + ((size_t)b * S_ + qrow) * INW + C_DQ + h * 128 + map * 64;
    const bf16_t* Kg = io.proj + (size_t)b * S_ * INW + C_DK + h * 128; const bf16_t* Vg = io.proj + (size_t)b * S_ * INW + C_DV + h * 128;
    const float b31 = io.rel_bias[31 * 8 + h] * LOG2E;
    const int NT = (q0 + 128) / 64;
    const int per = NT; int it0 = cv4_unit_base(b * 8 + h, qb) + wid * per; int nit = CV4_TOTAL - it0; nit = nit < 0 ? 0 : (nit > per ? per : nit);
    __syncthreads();
    if (tid < 128) dtab[tid] = io.rel_bias[t5_bucket(tid) * 8 + h] * LOG2E - b31;
    unsigned koff[2], voff[2];
#pragma unroll
    for (int i = 0; i < 2; ++i) { const int p = 2 * wid + i, row = 4 * p + (lane >> 4), c = (lane & 15) ^ (row & 7); koff[i] = (unsigned)(row * INW + c * 8);
        const int st = 2 * p + (lane >> 5), kk = (st >> 2) * 8 + ((lane & 31) >> 2), k = (kk & ~0xC) | ((kk & 4) << 1) | ((kk & 8) >> 1), col = (st & 3) * 32 + (lane & 3) * 8; voff[i] = (unsigned)(k * INW + col); }
    int sl_j = 0, sl_n = 2 * D2_SLOT;
#define D3_ISSUE(t, sl_) do { const bf16_t* kb_ = Kg + (size_t)(t) * 64 * INW; const bf16_t* vb_ = Vg + (size_t)(t) * 64 * INW; \
        _Pragma("unroll") for (int i_ = 0; i_ < 2; ++i_) { \
            __builtin_amdgcn_global_load_lds((const unsigned*)(kb_ + koff[i_]), (ALAS unsigned*)(lds + (sl_) + (2 * wid + i_) * 1024), 16, 0, 0); \
            __builtin_amdgcn_global_load_lds((const unsigned*)(vb_ + voff[i_]), (ALAS unsigned*)(lds + (sl_) + 16384 + (2 * wid + i_) * 1024), 16, 0, 0); } } while (0)
    int sk0, sk1, sdA = 0, sdB = 0, cr = 0;
    D3_ISSUE(0, 0); D3_ISSUE(1, D2_SLOT); sk0 = 4; sk1 = 0;
    if (nit > 0) { const float* src; unsigned char* dst; cv4_decode(cv, it0, src, dst); cv4_issue(src, stg, lane); sk0 += 2; sk1 += 2; sdA = 0; }
    if (nit > 1) { const float* src; unsigned char* dst; cv4_decode(cv, it0 + 1, src, dst); cv4_issue(src, stg + 2048, lane); sk0 += 2; sk1 += 2; sdA += 2; sdB = 0; }
    asm volatile("" ::: "memory");
    bf16x8 qr[4];
#pragma unroll
    for (int d0 = 0; d0 < 4; ++d0) qr[d0] = *(const bf16x8*)(Qp + d0 * 16 + hi * 8);
    f32x16 o[4] = {}; f32x16 negm;
#pragma unroll
    for (int r = 0; r < 16; ++r) negm[r] = b31;
    float mref = 0.f, l_reg = 0.f;
    const int vbase = (int)(unsigned)(uintptr_t)(lds + 16384) + v_rd_base(lane);
    for (int j = 0; j < NT; ++j) {
        const bool cvt = cr < nit;
        { const int sdx = (cr & 1) ? sdB : sdA; const int allow = cvt ? (sk0 < sdx ? sk0 : sdx) : sk0; VM_WAIT_LE(allow); }
        __builtin_amdgcn_s_barrier(); asm volatile("" ::: "memory");
        if (cvt) {
            const float* src; unsigned char* dst; cv4_decode(cv, it0 + cr, src, dst);
            const int n = lane & 31, kh = lane >> 5; const ALAS float* sp = (const ALAS float*)(stg + (cr & 1) * 2048);
            float v[8];
#pragma unroll
            for (int i = 0; i < 8; ++i) { const int k = 8 * kh + i; v[i] = sp[k * 32 + ((((n >> 2) ^ (k & 7)) << 2) | (n & 3))]; }
            asm volatile("s_waitcnt lgkmcnt(0)" ::: "memory");
            if (cr + 2 < nit) { const float* s2; unsigned char* d2; cv4_decode(cv, it0 + cr + 2, s2, d2); cv4_issue(s2, stg + (cr & 1) * 2048, lane); sk0 += 2; sk1 += 2; sdA += 2; sdB += 2; if (cr & 1) sdB = 0; else sdA = 0; }
            asm volatile("" ::: "memory");
            const float sc = cv.sc; typedef int i32x2_t __attribute__((ext_vector_type(2)));
            const i32x2_t w = {(int)pk4_fp8_att(v[0] * sc, v[1] * sc, v[2] * sc, v[3] * sc), (int)pk4_fp8_att(v[4] * sc, v[5] * sc, v[6] * sc, v[7] * sc)};
            *(__attribute__((address_space(1))) i32x2_t*)(dst + (size_t)n * LD_F8 + 8 * kh) = w;
            asm volatile("" ::: "memory");
            ++cr;
        }
        if (j + 2 < NT) { D3_ISSUE(j + 2, sl_n); sdA += 4; sdB += 4; sk0 = sk1 + 4; sk1 = 0; } else { sk0 = sk1; sk1 = 0; }
        asm volatile("" ::: "memory");
        const int k0 = j * 64; const ALAS char* Ks = lds + sl_j;
        f32x16 p0, p1;
#pragma unroll
        for (int d0 = 0; d0 < 4; ++d0) { const int cb = map * 128 + (d0 * 16 + hi * 8) * 2;
            const bf16x8 kb0 = *(const ALAS bf16x8*)(Ks + kswz<256>(r32, cb)), kb1 = *(const ALAS bf16x8*)(Ks + kswz<256>(32 + r32, cb));
            if (d0 == 0) { p0 = __builtin_amdgcn_mfma_f32_32x32x16_bf16(kb0, qr[0], negm, 0, 0, 0); p1 = __builtin_amdgcn_mfma_f32_32x32x16_bf16(kb1, qr[0], negm, 0, 0, 0); }
            else { p0 = __builtin_amdgcn_mfma_f32_32x32x16_bf16(kb0, qr[d0], p0, 0, 0, 0); p1 = __builtin_amdgcn_mfma_f32_32x32x16_bf16(kb1, qr[d0], p1, 0, 0, 0); } }
        if ((q0 + rg * 32) - (k0 + 63) < 113) {
#pragma unroll
            for (int r = 0; r < 16; ++r) { const int d0_ = qrow - (k0 + crow(r, hi)), d1_ = d0_ - 32;
                const float t0 = dtab[d0_ < 0 ? 0 : (d0_ < 127 ? d0_ : 127)], t1 = dtab[d1_ < 0 ? 0 : (d1_ < 127 ? d1_ : 127)];
                p0[r] = d0_ < 0 ? NEG_BIG : p0[r] + t0; p1[r] = d1_ < 0 ? NEG_BIG : p1[r] + t1; } }
        float mx0 = fmaxf(fmaxf(p0[0], p0[1]), p0[2]), mx1 = fmaxf(fmaxf(p0[3], p0[4]), p0[5]), mx2 = fmaxf(fmaxf(p1[0], p1[1]), p1[2]), mx3 = fmaxf(fmaxf(p1[3], p1[4]), p1[5]);
        mx0 = fmaxf(fmaxf(mx0, p0[6]), p0[7]); mx1 = fmaxf(fmaxf(mx1, p0[8]), p0[9]); mx2 = fmaxf(fmaxf(mx2, p1[6]), p1[7]); mx3 = fmaxf(fmaxf(mx3, p1[8]), p1[9]);
        mx0 = fmaxf(fmaxf(mx0, p0[10]), p0[11]); mx1 = fmaxf(fmaxf(mx1, p0[12]), p0[13]); mx2 = fmaxf(fmaxf(mx2, p1[10]), p1[11]); mx3 = fmaxf(fmaxf(mx3, p1[12]), p1[13]);
        mx0 = fmaxf(fmaxf(mx0, p0[14]), p0[15]); mx2 = fmaxf(fmaxf(mx2, p1[14]), p1[15]);
        float pmax = swap_max(fmaxf(fmaxf(mx0, mx1), fmaxf(mx2, mx3)));
        if (j == 0 || __any(pmax > THR2)) {
            const float dl = (j == 0) ? pmax : fmaxf(pmax, 0.f); mref += dl;
#pragma unroll
            for (int r = 0; r < 16; ++r) { p0[r] -= dl; p1[r] -= dl; negm[r] -= dl; }
            const float alpha = __builtin_amdgcn_exp2f(-dl); l_reg *= alpha;
            if (j > 0) { if (hi == 0) wsf[r32] = alpha; asm volatile("s_waitcnt lgkmcnt(0)" ::: "memory");
#pragma unroll
                for (int d = 0; d < 4; ++d)
#pragma unroll
                    for (int r = 0; r < 16; ++r) o[d][r] *= wsf[crow(r, hi)]; } }
#pragma unroll
        for (int r = 0; r < 16; ++r) { p0[r] = __builtin_amdgcn_exp2f(p0[r]); p1[r] = __builtin_amdgcn_exp2f(p1[r]); }
        float ps0 = p0[0] + p1[0], ps1 = p0[1] + p1[1], ps2 = p0[2] + p1[2], ps3 = p0[3] + p1[3];
#pragma unroll
        for (int r = 4; r < 16; r += 4) { ps0 += p0[r] + p1[r]; ps1 += p0[r + 1] + p1[r + 1]; ps2 += p0[r + 2] + p1[r + 2]; ps3 += p0[r + 3] + p1[r + 3]; }
        l_reg += swap_sum((ps0 + ps1) + (ps2 + ps3));
        bf16x8 pa0, pa1, pa2, pa3;
        pack_p(p0, p1, pa0, pa1, pa2, pa3);
        SBAR();
        pv_d0_pipe(o, vbase + sl_j, pa0, pa1, pa2, pa3);
        sl_j = (sl_j == 2 * D2_SLOT) ? 0 : sl_j + D2_SLOT; sl_n = (sl_n == 2 * D2_SLOT) ? 0 : sl_n + D2_SLOT;
    }
#undef D3_ISSUE
    while (cr < nit) {
        asm volatile("s_waitcnt vmcnt(0)" ::: "memory");
        const float* src; unsigned char* dst; cv4_decode(cv, it0 + cr, src, dst);
        const int n = lane & 31, kh = lane >> 5; const ALAS float* sp = (const ALAS float*)(stg + (cr & 1) * 2048);
        float v[8];
#pragma unroll
        for (int i = 0; i < 8; ++i) { const int k = 8 * kh + i; v[i] = sp[k * 32 + ((((n >> 2) ^ (k & 7)) << 2) | (n & 3))]; }
        asm volatile("s_waitcnt lgkmcnt(0)" ::: "memory");
        if (cr + 2 < nit) { const float* s2; unsigned char* d2; cv4_decode(cv, it0 + cr + 2, s2, d2); cv4_issue(s2, stg + (cr & 1) * 2048, lane); }
        asm volatile("" ::: "memory");
        const float sc = cv.sc; typedef int i32x2_t __attribute__((ext_vector_type(2)));
        const i32x2_t w = {(int)pk4_fp8_att(v[0] * sc, v[1] * sc, v[2] * sc, v[3] * sc), (int)pk4_fp8_att(v[4] * sc, v[5] * sc, v[6] * sc, v[7] * sc)};
        *(__attribute__((address_space(1))) i32x2_t*)(dst + (size_t)n * LD_F8 + 8 * kh) = w;
        ++cr;
    }
    if (hi == 0) wsf[32 + r32] = l_reg; asm volatile("s_waitcnt lgkmcnt(0)" ::: "memory");
    float rl[16];
#pragma unroll
    for (int r = 0; r < 16; ++r) rl[r] = __builtin_amdgcn_rcpf(wsf[32 + crow(r, hi)]);
    asm volatile("s_waitcnt vmcnt(0)" ::: "memory");
    __syncthreads();
    ALAS float* xch = (ALAS float*)lds + rg * 4096;
    if (map == 1) {
#pragma unroll
        for (int d = 0; d < 4; ++d)
#pragma unroll
            for (int r = 0; r < 16; ++r) xch[(d * 16 + r) * 64 + lane] = o[d][r] * rl[r]; }
    __syncthreads();
    if (map == 0) {
        float ss[16];
#pragma unroll
        for (int r = 0; r < 16; ++r) { float s = 0.f;
#pragma unroll
            for (int d = 0; d < 4; ++d) { const float yv = o[d][r] * rl[r] - io.lam * xch[(d * 16 + r) * 64 + lane]; o[d][r] = yv; s += yv * yv; }
            ss[r] = s; }
#pragma unroll
        for (int r = 0; r < 16; ++r) {
#pragma unroll
            for (int off = 1; off < 32; off <<= 1) ss[r] += __shfl_xor(ss[r], off); }
        float sg[4];
#pragma unroll
        for (int d = 0; d < 4; ++d) sg[d] = io.subg[d * 32 + r32] * 0.8f;
#pragma unroll
        for (int r = 0; r < 16; ++r) { const float rs = rsqrtf(ss[r] * (1.0f / 128.0f) + 1e-6f);
            bf16_t* yp = io.y + ((size_t)b * S_ + q0 + rg * 32 + crow(r, hi)) * YW + h * 128 + r32;
#pragma unroll
            for (int d = 0; d < 4; ++d) yp[d * 32] = (bf16_t)(cvtpk(o[d][r] * rs * sg[d], 0.f) & 0xffffu); }
    }
}
#undef VM_WAIT_LE
#undef SBAR
}
constexpr int NWAVES = 8;
constexpr int DM = 2048, NB = 2, SEQ = 8192, T = NB * SEQ, INW = 13312, ML = 256, NE = 32, FF = 2048, YW = 3072;
constexpr int NBF = 6144, NF8 = INW - NBF;
constexpr int NTILE_MAX = T * 4 / 256 + NE;
constexpr int P = NTILE_MAX * 256;
constexpr float NORM_EPS = 1e-6f;
constexpr float SC_W = 32.f, SC_XS = 8.f, SC_ACT = 4.f;
constexpr int SC_W_BYTE = 0x7a7a7a7a, SC_XS_BYTE = 0x7c7c7c7c, SC_ACT_BYTE = 0x7d7d7d7d;
constexpr size_t MiB = 1u << 20;
constexpr size_t WS_CTL = 0, CTL_ZERO_BYTES = MiB / 4;
constexpr size_t WS_WIN = 1 * MiB;
constexpr size_t WS_WKV = WS_WIN + 54 * MiB;
constexpr size_t WS_WBR = WS_WKV + 9 * MiB;
constexpr size_t WS_WOUT = WS_WBR + 13 * MiB;
constexpr size_t WS_W1 = WS_WOUT + 9 * MiB;
constexpr size_t WS_W2 = WS_W1 + 273 * MiB;
constexpr size_t WS_H = WS_W2 + 137 * MiB;
constexpr size_t WS_MEMN = WS_H + 67 * MiB;
constexpr size_t WS_PROJ = WS_MEMN + 3 * MiB;
constexpr size_t WS_KV = WS_PROJ + 419 * MiB;
constexpr size_t WS_Y = WS_KV + 3 * MiB;
constexpr size_t WS_MERGED = WS_Y + 99 * MiB;
constexpr size_t WS_X1 = WS_MERGED + 67 * MiB;
constexpr size_t WS_XS = WS_X1 + 128 * MiB;
constexpr size_t WS_ACT = WS_XS + 154 * MiB;
constexpr size_t WS_YS = WS_ACT + 154 * MiB;
constexpr size_t WS_ROUTE = WS_YS + 288 * MiB;
constexpr size_t WS_H8 = WS_ROUTE + 2 * MiB;
constexpr size_t WS_WG8 = WS_H8 + 35 * MiB;
constexpr size_t WS_WO8 = WS_WG8 + 28 * MiB;
constexpr size_t WS_END = WS_WO8 + 5 * MiB;
static_assert((size_t)13312 * LD_D * 2 <= 54 * MiB && (size_t)131072 * LD_F8 <= 273 * MiB && (size_t)65536 * LD_F8 <= 137 * MiB && (size_t)16384 * LD_D * 2 <= 67 * MiB && (size_t)16384 * LD_P * 2 <= 419 * MiB && (size_t)16384 * LD_Y * 2 <= 99 * MiB && (size_t)73728 * LD_F8 <= 154 * MiB, "d_ws map");
constexpr size_t RT_RSTD = 0, RT_TOPI = 256 * 1024, RT_TOPG = 512 * 1024, RT_SLOT = 768 * 1024, RT_POS = 1024 * 1024;
constexpr int CW_BAR = 4096, N_BAR_REGIONS = 16;
constexpr int CW_QDIFF = 61440, CW_QSB = 61504, CW_QMEM = 61568, CW_KVDONE = 61632, CW_CNT = 61696, CW_QDX = 62464;
constexpr int RING_BYTES = 131072, LDSCTL_OFF = RING_BYTES, MISC_OFF = LDSCTL_OFF + 320, TAB_OFF = LDSCTL_OFF + 1024;
constexpr int LDS_BYTES = 147456;

#define GAS __attribute__((address_space(1)))
#define LAS __attribute__((address_space(3)))
typedef unsigned short bf16;
typedef unsigned v4u __attribute__((ext_vector_type(4)));
typedef unsigned v2u __attribute__((ext_vector_type(2)));
typedef float f32x4 __attribute__((ext_vector_type(4)));
typedef float f32x16 __attribute__((ext_vector_type(16)));
typedef GAS unsigned gu32;
#define RLX_AGENT __ATOMIC_RELAXED, __HIP_MEMORY_SCOPE_AGENT
#define LDS_WAIT() asm volatile("s_waitcnt lgkmcnt(0)" ::: "memory")
__device__ __forceinline__ unsigned f2bf(float f) { unsigned u = __builtin_bit_cast(unsigned, f); return (u + 0x7fffu + ((u >> 16) & 1u)) >> 16; }
__device__ __forceinline__ unsigned pk2(float lo, float hi) { unsigned r; asm("v_cvt_pk_bf16_f32 %0, %1, %2" : "=v"(r) : "v"(lo), "v"(hi)); return r; }
__device__ __forceinline__ float bf2f(unsigned short v) { return __uint_as_float((unsigned)v << 16); }
__device__ __forceinline__ float wave_sum(float v) {
#pragma unroll
    for (int o = 1; o < 64; o <<= 1) v += __shfl_xor(v, o);
    return v;
}
#define XB_TMO      128
#define XB_XCNT(j)  (256  + 64 * (j))
#define XB_XSUB(j)  (1280 + 64 * (j))
#define XB_XGEN(j)  (2304 + 64 * (j))
#define XB_TOP      3328
#define XB_TOPGEN   3392
#define XCD_BAR_WORDS 3456
#define XB_SPIN_CAP (1u << 18)

__device__ __forceinline__ unsigned xb_ld(unsigned* p)              { return __hip_atomic_load(p, __ATOMIC_RELAXED, __HIP_MEMORY_SCOPE_AGENT); }
__device__ __forceinline__ unsigned xb_add(unsigned* p, unsigned v) { return __hip_atomic_fetch_add(p, v, __ATOMIC_RELAXED, __HIP_MEMORY_SCOPE_AGENT); }
__device__ __forceinline__ unsigned xb_xcc_id() { return (unsigned)__builtin_amdgcn_s_getreg((3 << 11) | 20) & 0xFu; }
#define XB_SPIN(cond, bar) do { unsigned _sp = 0; while (cond) { __builtin_amdgcn_s_sleep(1); \
    if ((++_sp & 255u) == 0u) { if (xb_ld(&(bar)[XB_TMO])) break; if (_sp > XB_SPIN_CAP) { atomicAdd(&(bar)[XB_TMO], 1u); break; } } } } while (0)

struct XcdBarrier {
    unsigned* bar; unsigned x;
    volatile LAS unsigned* st;
};

__device__ __forceinline__ XcdBarrier xcd_barrier_post(unsigned* bar, volatile LAS unsigned* st) {
    XcdBarrier b; b.bar = bar; b.x = xb_xcc_id(); b.st = st;
    if (threadIdx.x == 0) (void)xb_add(&bar[XB_XCNT(b.x)], 1u);
    return b;
}
__device__ __forceinline__ void xcd_barrier_complete(unsigned* bar, unsigned x, unsigned& nloc, unsigned& nx) {
    const unsigned G = gridDim.x * gridDim.y * gridDim.z;
    unsigned sum, cnt, mine, sp = 0u;
    for (;;) {
        sum = 0u; cnt = 0u; mine = 0u;
#pragma unroll
        for (unsigned j = 0; j < 16; ++j) { const unsigned c = xb_ld(&bar[XB_XCNT(j)]); sum += c; cnt += (c > 0u) ? 1u : 0u; mine = (j == x) ? c : mine; }
        if (sum == G) break;
        __builtin_amdgcn_s_sleep(1);
        if ((++sp & 255u) == 0u) { if (xb_ld(&bar[XB_TMO])) break; if (sp > XB_SPIN_CAP) { atomicAdd(&bar[XB_TMO], 1u); break; } }
    }
    nloc = mine > 0u ? mine : 1u; nx = cnt > 0u ? cnt : 1u;
}

__device__ __forceinline__ void xcd_barrier(const XcdBarrier& b) {
    asm volatile("s_waitcnt vmcnt(0)" ::: "memory");
    __syncthreads();
    if (threadIdx.x == 0) {
        unsigned* bar = b.bar;
        __builtin_amdgcn_s_waitcnt(0);
        unsigned nloc = b.st[0], nx = b.st[1];
        if (nloc == 0u) { xcd_barrier_complete(bar, b.x, nloc, nx); b.st[0] = nloc; b.st[1] = nx; }
        const unsigned old = xb_add(&bar[XB_XSUB(b.x)], 1u);
        const unsigned gen = old / nloc;
        if (old + 1u == (gen + 1u) * nloc) {
            __builtin_amdgcn_fence(__ATOMIC_RELEASE, "agent");
            asm volatile("s_waitcnt vmcnt(0)" ::: "memory");
            const unsigned og = xb_add(&bar[XB_TOP], 1u);
            const unsigned tg = og / nx;
            if (og + 1u == (tg + 1u) * nx) xb_add(&bar[XB_TOPGEN], 1u);
            else XB_SPIN(xb_ld(&bar[XB_TOPGEN]) == tg, bar);
            __builtin_amdgcn_fence(__ATOMIC_ACQUIRE, "agent");
            xb_add(&bar[XB_XGEN(b.x)], 1u);
            asm volatile("s_waitcnt vmcnt(0)" ::: "memory");
        } else {
            XB_SPIN(xb_ld(&bar[XB_XGEN(b.x)]) == gen, bar);
            __builtin_amdgcn_fence(__ATOMIC_ACQUIRE, "agent");
            asm volatile("s_waitcnt vmcnt(0)" ::: "memory");
        }
    }
    __syncthreads();
}
__device__ __forceinline__ void p0_transpose_item(const float* W, int N, int k0, int n0, bf16* dst, int ldt, LAS float* scr, int lane) {
#pragma unroll 8
    for (int i = 0; i < 32; ++i) { const int kk = 2 * i + (lane >> 5); scr[kk * 33 + (lane & 31)] = W[(size_t)(k0 + kk) * N + n0 + (lane & 31)]; }
    LDS_WAIT(); asm volatile("" ::: "memory");
    const int c = lane & 7;
#pragma unroll
    for (int j = 0; j < 4; ++j) { const int n = (lane >> 3) + 8 * j; const LAS float* s = scr + (8 * c) * 33 + n;
        v4u o; o.x = pk2(s[0 * 33], s[1 * 33]); o.y = pk2(s[2 * 33], s[3 * 33]); o.z = pk2(s[4 * 33], s[5 * 33]); o.w = pk2(s[6 * 33], s[7 * 33]);
        *(GAS v4u*)(dst + (size_t)n * ldt + 8 * c) = o; }
    LDS_WAIT(); asm volatile("" ::: "memory");
}
__device__ __forceinline__ unsigned pk4_fp8(float a, float b, float c, float d) {
    a = fminf(fmaxf(a, -448.f), 448.f); b = fminf(fmaxf(b, -448.f), 448.f); c = fminf(fmaxf(c, -448.f), 448.f); d = fminf(fmaxf(d, -448.f), 448.f);
    int w = 0; w = __builtin_amdgcn_cvt_pk_fp8_f32(a, b, w, false); w = __builtin_amdgcn_cvt_pk_fp8_f32(c, d, w, true); return (unsigned)w;
}
__device__ __forceinline__ void p0_transpose_item_fp8(const float* W, int N, int k0, int n0, unsigned char* dst, int ldt, float sc, LAS float* scr, int lane) {
#pragma unroll 8
    for (int i = 0; i < 32; ++i) { const int kk = 2 * i + (lane >> 5); scr[kk * 33 + (lane & 31)] = __builtin_nontemporal_load(W + (size_t)(k0 + kk) * N + n0 + (lane & 31)); }
    LDS_WAIT(); asm volatile("" ::: "memory");
    const int c = lane & 3;
#pragma unroll
    for (int j = 0; j < 2; ++j) { const int n = (lane >> 2) + 16 * j; const LAS float* s = scr + (16 * c) * 33 + n;
        v4u o; o.x = pk4_fp8(sc * s[0 * 33], sc * s[1 * 33], sc * s[2 * 33], sc * s[3 * 33]); o.y = pk4_fp8(sc * s[4 * 33], sc * s[5 * 33], sc * s[6 * 33], sc * s[7 * 33]);
        o.z = pk4_fp8(sc * s[8 * 33], sc * s[9 * 33], sc * s[10 * 33], sc * s[11 * 33]); o.w = pk4_fp8(sc * s[12 * 33], sc * s[13 * 33], sc * s[14 * 33], sc * s[15 * 33]);
        *(GAS v4u*)(dst + (size_t)n * ldt + 16 * c) = o; }
    LDS_WAIT(); asm volatile("" ::: "memory");
}
__device__ __forceinline__ void rms_row_to_bf16(const float* xrow, const float* g, bf16* orow, unsigned char* o8row, float sc8, int lane) {
    const GAS f32x4* xr = (const GAS f32x4*)xrow + lane; const GAS f32x4* gr = (const GAS f32x4*)g + lane;
    f32x4 v[8]; float s = 0.f;
#pragma unroll
    for (int j = 0; j < 8; ++j) { v[j] = __builtin_nontemporal_load(xr + 64 * j); s += (v[j].x * v[j].x + v[j].y * v[j].y) + (v[j].z * v[j].z + v[j].w * v[j].w); }
    const float rstd = rsqrtf(wave_sum(s) * (1.f / DM) + NORM_EPS);
    GAS unsigned long long* o8 = (GAS unsigned long long*)orow + lane;
#pragma unroll
    for (int j = 0; j < 8; ++j) { const f32x4 gg = gr[64 * j]; v[j].x *= rstd * gg.x; v[j].y *= rstd * gg.y; v[j].z *= rstd * gg.z; v[j].w *= rstd * gg.w;
        __builtin_nontemporal_store((unsigned long long)pk2(v[j].x, v[j].y) | ((unsigned long long)pk2(v[j].z, v[j].w) << 32), o8 + 64 * j); }
    if (o8row) { GAS unsigned* q4 = (GAS unsigned*)o8row + lane;
#pragma unroll
        for (int j = 0; j < 8; ++j) __builtin_nontemporal_store(pk4_fp8(v[j].x * sc8, v[j].y * sc8, v[j].z * sc8, v[j].w * sc8), q4 + 64 * j); }
}
struct CvtItem { const float* src; unsigned char* dst; int N, ldt; };
__device__ __forceinline__ void cvt_load(const CvtItem& d, int lane, f32x4 (&v)[8]) {
    const float* p = d.src + (size_t)(lane >> 3) * d.N + 4 * (lane & 7);
#pragma unroll
    for (int i = 0; i < 8; ++i) v[i] = __builtin_nontemporal_load((const f32x4*)(p + (size_t)(8 * i) * d.N));
}
__device__ __forceinline__ void cvt_to_lds(const f32x4 (&v)[8], LAS float* scr, int lane) {
    LAS float* s = scr + (lane >> 3) * 33 + 4 * (lane & 7);
#pragma unroll
    for (int i = 0; i < 8; ++i) { s[(8 * i) * 33 + 0] = v[i].x; s[(8 * i) * 33 + 1] = v[i].y; s[(8 * i) * 33 + 2] = v[i].z; s[(8 * i) * 33 + 3] = v[i].w; }
    LDS_WAIT(); asm volatile("" ::: "memory");
}
template <bool FP8> __device__ __forceinline__ void cvt_from_lds(const CvtItem& d, LAS float* scr, int lane, float sc) {
    if (FP8) { const int c = lane & 3;
#pragma unroll
        for (int j = 0; j < 2; ++j) { const int n = (lane >> 2) + 16 * j; const LAS float* s = scr + (16 * c) * 33 + n;
            v4u o; o.x = pk4_fp8(sc * s[0 * 33], sc * s[1 * 33], sc * s[2 * 33], sc * s[3 * 33]); o.y = pk4_fp8(sc * s[4 * 33], sc * s[5 * 33], sc * s[6 * 33], sc * s[7 * 33]);
            o.z = pk4_fp8(sc * s[8 * 33], sc * s[9 * 33], sc * s[10 * 33], sc * s[11 * 33]); o.w = pk4_fp8(sc * s[12 * 33], sc * s[13 * 33], sc * s[14 * 33], sc * s[15 * 33]);
            *(GAS v4u*)(d.dst + (size_t)n * d.ldt + 16 * c) = o; } }
    else { const int c = lane & 7;
#pragma unroll
        for (int j = 0; j < 4; ++j) { const int n = (lane >> 3) + 8 * j; const LAS float* s = scr + (8 * c) * 33 + n;
            v4u o; o.x = pk2(s[0 * 33], s[1 * 33]); o.y = pk2(s[2 * 33], s[3 * 33]); o.z = pk2(s[4 * 33], s[5 * 33]); o.w = pk2(s[6 * 33], s[7 * 33]);
            *(GAS v4u*)(d.dst + (size_t)n * d.ldt + 16 * c) = o; } }
    LDS_WAIT(); asm volatile("" ::: "memory");
}
__device__ __forceinline__ void cvt8_load(const CvtItem& d, int lane, f32x4 (&v)[8]) {
    const float* p = d.src + (size_t)(4 * (lane >> 3)) * d.N + 4 * (lane & 7);
#pragma unroll
    for (int j = 0; j < 4; ++j) { v[j] = __builtin_nontemporal_load((const f32x4*)(p + (size_t)j * d.N)); v[4 + j] = __builtin_nontemporal_load((const f32x4*)(p + (size_t)(32 + j) * d.N)); }
}
__device__ __forceinline__ unsigned pk4_fp8_w(float a, float b, float c, float d) { int w = __float_as_int(a); w = __builtin_amdgcn_cvt_pk_fp8_f32(a, b, w, false); w = __builtin_amdgcn_cvt_pk_fp8_f32(c, d, w, true); return (unsigned)w; }
__device__ __forceinline__ void cvt8_to_lds(const f32x4 (&v)[8], LAS float* scr, int lane, float sc) {
    LAS unsigned* s = (LAS unsigned*)scr + (4 * (lane & 7)) * 18 + (lane >> 3);
#pragma unroll
    for (int nn = 0; nn < 4; ++nn) { s[nn * 18] = pk4_fp8_w(sc * v[0][nn], sc * v[1][nn], sc * v[2][nn], sc * v[3][nn]); s[nn * 18 + 8] = pk4_fp8_w(sc * v[4][nn], sc * v[5][nn], sc * v[6][nn], sc * v[7][nn]); }
    LDS_WAIT(); asm volatile("" ::: "memory");
}
__device__ __forceinline__ void cvt8_from_lds(const CvtItem& d, LAS float* scr, int lane) {
    const int c = lane & 3;
#pragma unroll
    for (int j = 0; j < 2; ++j) { const int n = (lane >> 2) + 16 * j; const LAS v2u* s = (const LAS v2u*)((LAS unsigned*)scr + n * 18 + 4 * c); const v2u lo = s[0], hi = s[1];
        __builtin_nontemporal_store((v4u){lo.x, lo.y, hi.x, hi.y}, (GAS v4u*)(d.dst + (size_t)n * d.ldt + 16 * c)); }
    LDS_WAIT(); asm volatile("" ::: "memory");
}
__device__ __forceinline__ void cvt16_to_lds(const f32x4 (&v)[8], LAS float* scr, int lane) {
    LAS v2u* s = (LAS v2u*)((LAS unsigned*)scr + (4 * (lane & 7)) * 36 + 2 * (lane >> 3));
#pragma unroll
    for (int nn = 0; nn < 4; ++nn) { s[nn * 18] = (v2u){pk2(v[0][nn], v[1][nn]), pk2(v[2][nn], v[3][nn])}; s[nn * 18 + 8] = (v2u){pk2(v[4][nn], v[5][nn]), pk2(v[6][nn], v[7][nn])}; }
    LDS_WAIT(); asm volatile("" ::: "memory");
}
__device__ __forceinline__ void cvt16_from_lds(const CvtItem& d, LAS float* scr, int lane) {
    const int c = lane & 7;
#pragma unroll
    for (int j = 0; j < 4; ++j) { const int n = (lane >> 3) + 8 * j; __builtin_nontemporal_store(*(const LAS v4u*)((LAS unsigned*)scr + n * 36 + 4 * c), (GAS v4u*)(d.dst + (size_t)n * d.ldt + 16 * c)); }
    LDS_WAIT(); asm volatile("" ::: "memory");
}
template <bool FP8, class DEC> __device__ __forceinline__ void cvt_run(const DEC& dec, int first, int stride, int count, LAS float* scr, int lane, float sc) {
    if (count <= 0) return;
    f32x4 v0[8], v1[8], v2[8]; CvtItem d0 = dec(first), d1 = d0, d2 = d0;
#define CVT_LOAD(D, V) cvt8_load(D, lane, V)
    CVT_LOAD(d0, v0);
    if (count > 1) { d1 = dec(first + stride); CVT_LOAD(d1, v1); }
    if (count > 2) { d2 = dec(first + 2 * stride); CVT_LOAD(d2, v2); }
#define CVT_STEP(V, D, NXT) do { if constexpr (FP8) cvt8_to_lds(V, scr, lane, sc); else cvt16_to_lds(V, scr, lane); const CvtItem cur_ = D; if ((NXT) < count) { D = dec(first + (NXT) * stride); CVT_LOAD(D, V); } \
        if constexpr (FP8) cvt8_from_lds(cur_, scr, lane); else cvt16_from_lds(cur_, scr, lane); } while (0)
    for (int i = 0; i < count; i += 3) {
        CVT_STEP(v0, d0, i + 3);
        if (i + 1 < count) CVT_STEP(v1, d1, i + 4);
        if (i + 2 < count) CVT_STEP(v2, d2, i + 5);
    }
#undef CVT_STEP
#undef CVT_LOAD
}
struct CvtTile { const float* src; unsigned char* dst; int N; };
constexpr int CVT_IMG_BYTES = 128 * 33 * 4;
__device__ __forceinline__ void cvtt_load(const CvtTile& d, int wave, int lane, f32x4 (&v)[8]) {
    const float* p = d.src + (size_t)(16 * wave + 4 * (lane >> 4)) * d.N + 4 * (lane & 15);
#pragma unroll
    for (int ps = 0; ps < 2; ++ps)
#pragma unroll
        for (int j = 0; j < 4; ++j) v[ps * 4 + j] = __builtin_nontemporal_load((const f32x4*)(p + (size_t)j * d.N + 64 * ps));
}
template <class DEC> __device__ __forceinline__ void cvt_wg(const DEC& dec, int first, int count, LAS unsigned char* lds, int wave, int lane, float sc) {
    if (count <= 0) return;
    const int tid = wave * 64 + lane;
    f32x4 va[8], vb[8], vc[8], vd[8]; CvtTile d0 = dec(first), d1 = d0, d2 = d0, d3 = d0;
    cvtt_load(d0, wave, lane, va);
    if (count > 1) { d1 = dec(first + 1); cvtt_load(d1, wave, lane, vb); }
    if (count > 2) { d2 = dec(first + 2); cvtt_load(d2, wave, lane, vc); }
    if (count > 3) { d3 = dec(first + 3); cvtt_load(d3, wave, lane, vd); }
#define CVTT_STEP(V, D, NXT, B) do { LAS unsigned* img = (LAS unsigned*)(lds + (B) * CVT_IMG_BYTES); { LAS unsigned* wp = img + (4 * (lane & 15)) * 33 + 4 * wave + (lane >> 4); \
            _Pragma("unroll") for (int ps = 0; ps < 2; ++ps) _Pragma("unroll") for (int nn = 0; nn < 4; ++nn) \
                wp[(64 * ps + nn) * 33] = pk4_fp8_w(sc * V[ps * 4 + 0][nn], sc * V[ps * 4 + 1][nn], sc * V[ps * 4 + 2][nn], sc * V[ps * 4 + 3][nn]); } \
        const CvtTile cur_ = D; if ((NXT) < count) { D = dec(first + (NXT)); cvtt_load(D, wave, lane, V); } \
        __syncthreads(); \
        _Pragma("unroll") for (int r = 0; r < 2; ++r) { const int q = tid + 512 * r, n = q >> 3, part = q & 7; const LAS unsigned* sp = img + n * 33 + 4 * part; \
            __builtin_nontemporal_store((v4u){sp[0], sp[1], sp[2], sp[3]}, (GAS v4u*)(cur_.dst + (size_t)n * LD_F8 + 16 * part)); } } while (0)
    for (int i = 0; i < count; i += 4) {
        CVTT_STEP(va, d0, i + 4, 0);
        if (i + 1 < count) CVTT_STEP(vb, d1, i + 5, 1);
        if (i + 2 < count) CVTT_STEP(vc, d2, i + 6, 0);
        if (i + 3 < count) CVTT_STEP(vd, d3, i + 7, 1);
    }
#undef CVTT_STEP
    __syncthreads();
}
#ifndef CVT_IN_P0
#define CVT_IN_P0 0
#endif
#ifndef P4_FP8
#define P4_FP8 0
#endif
#ifndef F8_VTILES
#define F8_VTILES 0x00F00F00ull
#endif
constexpr unsigned long long F8_TILES = (F8_VTILES) | 0xFFFFFFF000000ull, BF_TILES = 0xFFFFFFull & ~(unsigned long long)(F8_VTILES);
constexpr int NT_F8 = __builtin_popcountll(F8_TILES), NT_BF = __builtin_popcountll(BF_TILES);
struct P0Dec {
    const float *w_in, *w_kv, *w_bd, *w_bs, *w_bm, *w_out; bf16 *Wt_in, *Wt_kv, *Wt_br, *Wt_out;
    __device__ __forceinline__ CvtItem operator()(int r) const {
        constexpr int I_IN = 32 * (8 * NT_BF), I_KV = 32 * 64, I_BR = 16 * 64;
        const float* src; unsigned char* dst; int N = 2048, ldt = LD_D * 2;
        if (r < I_IN) { const int nblk = 8 * NT_BF, k0 = 64 * (r / nblk), nb = r % nblk, n0 = 256 * pg8::nth_bit(BF_TILES, nb >> 3) + 32 * (nb & 7); src = w_in + (size_t)k0 * INW + n0; dst = (unsigned char*)(Wt_in + (size_t)n0 * LD_D + k0); N = INW; }
        else if (r < I_IN + I_KV) { r -= I_IN; const int k0 = 64 * (r / 64), n0 = 32 * (r % 64); src = w_kv + (size_t)k0 * 2048 + n0; dst = (unsigned char*)(Wt_kv + (size_t)n0 * LD_D + k0); }
        else if (r < I_IN + I_KV + I_BR) { r -= I_IN + I_KV; const int k0 = 64 * (r / 64), n0 = 32 * (r % 64); src = w_bd + (size_t)k0 * 2048 + n0; dst = (unsigned char*)(Wt_br + (size_t)n0 * LD_Y + k0); ldt = LD_Y * 2; }
        else if (r < I_IN + I_KV + 2 * I_BR) { r -= I_IN + I_KV + I_BR; const int k0 = 64 * (r / 64), n0 = 32 * (r % 64); src = w_bs + (size_t)k0 * 2048 + n0; dst = (unsigned char*)(Wt_br + (size_t)n0 * LD_Y + 1024 + k0); ldt = LD_Y * 2; }
        else if (r < I_IN + I_KV + 3 * I_BR) { r -= I_IN + I_KV + 2 * I_BR; const int k0 = 64 * (r / 64), n0 = 32 * (r % 64); src = w_bm + (size_t)k0 * 2048 + n0; dst = (unsigned char*)(Wt_br + (size_t)n0 * LD_Y + 2048 + k0); ldt = LD_Y * 2; }
        else { r -= I_IN + I_KV + 3 * I_BR; const int k0 = 64 * (r / 64), n0 = 32 * (r % 64); src = w_out + (size_t)k0 * 2048 + n0; dst = (unsigned char*)(Wt_out + (size_t)n0 * LD_D + k0); }
        return CvtItem{src, dst, N, ldt};
    }
};
#ifndef MK_ATT
#define MK_ATT 15
#endif
struct Args {
    const float* in[25]; float* out; unsigned char* ws; int ph_lo, ph_hi, li, pad;
};
constexpr int N_PHASES = 10;

__device__ __forceinline__ int dequeue(gu32* head, volatile LAS int* slot) {
    __syncthreads();
    if (threadIdx.x == 0) *slot = (int)__hip_atomic_fetch_add(head, 1u, RLX_AGENT);
    __syncthreads();
    return *slot;
}
__device__ __forceinline__ int dequeue_diff(gu32* qbase, int bx, volatile LAS int* slot, int& qx) {
    __syncthreads();
    if (threadIdx.x < 64) { const int lane = threadIdx.x; int li = -1, q = bx & 7;
        unsigned got = 0; if (lane == 0) got = __hip_atomic_fetch_add(qbase + 16 * q, 1u, RLX_AGENT);
        got = (unsigned)__builtin_amdgcn_readfirstlane((int)got);
        if (got < 128u) li = (int)got;
        else for (;;) {
            const unsigned h = (lane >= 1 && lane < 8) ? __hip_atomic_load(qbase + 16 * ((bx + lane) & 7), RLX_AGENT) : 128u;
            const unsigned long long m = __ballot(h < 128u);
            if (m == 0ull) break;
            q = (bx + (__ffsll((long long)m) - 1)) & 7;
            got = 0; if (lane == 0) got = __hip_atomic_fetch_add(qbase + 16 * q, 1u, RLX_AGENT);
            got = (unsigned)__builtin_amdgcn_readfirstlane((int)got);
            if (got < 128u) { li = (int)got; break; }
        }
        if (lane == 0) { slot[0] = li; slot[1] = q; } }
    __syncthreads();
    qx = slot[1]; return slot[0];
}
__device__ __forceinline__ void build_tile0(const gu32* cnt, volatile LAS int* tile0) {
    __syncthreads();
    if (threadIdx.x < 64) {
        const int lane = threadIdx.x; int t = 0; if (lane < NE) t = ((int)__hip_atomic_load(cnt + lane, RLX_AGENT) + 255) >> 8;
        int incl = t;
#pragma unroll
        for (int o = 1; o < 32; o <<= 1) { const int v = __shfl_up(incl, o); if (lane >= o) incl += v; }
        if (lane < NE) tile0[lane] = incl - t;
        if (lane == NE - 1) tile0[NE] = incl; }
    __syncthreads();
}

__device__ __forceinline__ void moe_fill_tab(volatile LAS int* tile0, volatile LAS int* tab, int nN, int G, int c) {
    if (threadIdx.x < 32) { const int i = threadIdx.x, L = i * G + c; int pm = -1, pn = 0;
        if (L < tile0[NE] * nN) { int e = 0; for (int k = 1; k < NE; ++k) e += (L >= tile0[k] * nN) ? 1 : 0;
            const int t0 = tile0[e], me = tile0[e + 1] - t0, rem = L - t0 * nN; pm = t0 + rem % me; pn = e * nN + rem / me; }
        tab[2 * i] = pm; tab[2 * i + 1] = pn; }
    __syncthreads();
}

template <class SCH> __device__ __forceinline__ void order_fill_tab(const SCH& S, volatile LAS int* tab) {
    __syncthreads();
    if (threadIdx.x < 32) { pg8::Unit u{0, 0}; const bool ok = S.next((int)threadIdx.x, u); tab[2 * threadIdx.x] = ok ? u.pm : -1; tab[2 * threadIdx.x + 1] = u.pn; }
    __syncthreads();
}

__global__ void __launch_bounds__(NWAVES * 64, 2) fwd_kernel(Args args) {
    extern __shared__ __attribute__((aligned(16))) unsigned char lds_raw[];
    LAS unsigned char* lds = (LAS unsigned char*)lds_raw;
    volatile LAS unsigned* MISC = (volatile LAS unsigned*)(lds + MISC_OFF);
    volatile LAS int* tile0 = (volatile LAS int*)(lds + TAB_OFF);
    volatile LAS int* dq_slot = (volatile LAS int*)(lds + TAB_OFF + 256);
    const int tid = threadIdx.x, lane = tid & 63, wave = __builtin_amdgcn_readfirstlane(tid >> 6);
    const int G = gridDim.x; const int bx = blockIdx.x; const int vcu = (G % 8 == 0) ? (bx % 8) * (G / 8) + bx / 8 : bx;
    unsigned char* ws = args.ws;
    gu32* ctl = (gu32*)(ws + WS_CTL);
    const float* x = args.in[0]; const float* mem = args.in[1]; const float* g_mix = args.in[2]; const float* w_in = args.in[3]; const float* b_gate = args.in[4];
    const float* rel_bias = args.in[5]; const float* lq1 = args.in[6]; const float* lk1 = args.in[7]; const float* lq2 = args.in[8]; const float* lk2 = args.in[9];
    const float* subg = args.in[10]; const float* g_mem = args.in[11]; const float* w_kv = args.in[12]; const float* w_bd = args.in[13]; const float* w_bs = args.in[14];
    const float* w_bm = args.in[15]; const float* w_out = args.in[16]; const float* g_ffn = args.in[17]; const float* w_r = args.in[18]; const float* b_r = args.in[19];
    const float* w1 = args.in[20]; const float* b1 = args.in[21]; const float* w2 = args.in[22]; const float* b2 = args.in[23]; const float* g_final = args.in[24];
    bf16* Wt_in = (bf16*)(ws + WS_WIN); bf16* Wt_kv = (bf16*)(ws + WS_WKV); bf16* Wt_br = (bf16*)(ws + WS_WBR); bf16* Wt_out = (bf16*)(ws + WS_WOUT);
    bf16* Wt_1 = (bf16*)(ws + WS_W1); bf16* Wt_2 = (bf16*)(ws + WS_W2);
    bf16* Hb = (bf16*)(ws + WS_H); bf16* MemN = (bf16*)(ws + WS_MEMN); bf16* Proj = (bf16*)(ws + WS_PROJ); bf16* KV = (bf16*)(ws + WS_KV); bf16* Yb = (bf16*)(ws + WS_Y);
    bf16* Merged = (bf16*)(ws + WS_MERGED); float* X1 = (float*)(ws + WS_X1); bf16* XS = (bf16*)(ws + WS_XS); bf16* ACT = (bf16*)(ws + WS_ACT); bf16* YS = (bf16*)(ws + WS_YS);
    unsigned char* H8 = ws + WS_H8; unsigned char* Wg8 = ws + WS_WG8;
    float* r_rstd = (float*)(ws + WS_ROUTE + RT_RSTD); int* r_topi = (int*)(ws + WS_ROUTE + RT_TOPI); float* r_topg = (float*)(ws + WS_ROUTE + RT_TOPG);
    int* r_slot = (int*)(ws + WS_ROUTE + RT_SLOT); int* r_pos = (int*)(ws + WS_ROUTE + RT_POS);

    for (int u = tid; u < (LDS_BYTES - LDSCTL_OFF) / 4; u += NWAVES * 64) ((LAS unsigned*)(lds + LDSCTL_OFF))[u] = 0u;
    __syncthreads();
    XcdBarrier bar = xcd_barrier_post((unsigned*)(ctl + CW_BAR) + args.li * XCD_BAR_WORDS, MISC + 8);
    const int lo = args.ph_lo, hi = args.ph_hi;
#ifndef MK_PHMASK
#define MK_PHMASK 0x3ffu
#endif
#define IN(k) ((((MK_PHMASK) >> (k)) & 1u) && lo <= (k) && (k) < hi)
#define SEAM(k) do { if (IN(k) && IN((k) + 1)) xcd_barrier(bar); } while (0)
    const int gw = vcu * NWAVES + wave, NGW = G * NWAVES;

    if (IN(0)) {
        LAS float* scr = (LAS float*)(lds + wave * 16384);
        constexpr int I_IN = 32 * (8 * NT_BF), I_KV = 32 * 64, I_BR = 16 * 64, I_OUT = 32 * 64, I_G8 = 32 * (8 * NT_F8);
        constexpr int NITEMS = I_IN + I_KV + 3 * I_BR + I_OUT;
        const P0Dec dec{w_in, w_kv, w_bd, w_bs, w_bm, w_out, Wt_in, Wt_kv, Wt_br, Wt_out};
        cvt_run<false>(dec, gw, NGW, (NITEMS - gw + NGW - 1) / NGW, scr, lane, 1.f);
        {   auto decg = [=](int r) -> CvtItem { const int k0 = 64 * (r / (8 * NT_F8)), nb = r % (8 * NT_F8), n0 = 256 * pg8::nth_bit(F8_TILES, nb >> 3) + 32 * (nb & 7);
                return CvtItem{w_in + (size_t)k0 * INW + n0, Wg8 + (size_t)n0 * LD_F8 + k0, INW, LD_F8}; };
            cvt_run<true>(decg, gw, NGW, (I_G8 - gw + NGW - 1) / NGW, scr, lane, SC_W); }
#if defined(PROBE_REP) && PROBE_REP == 0
        cvt_run<false>(dec, gw, NGW, (NITEMS - gw + NGW - 1) / NGW, scr, lane, 1.f);
        for (int m = gw; m < T; m += NGW) rms_row_to_bf16(x + (size_t)m * DM, g_mix, Hb + (size_t)m * LD_D, H8 + (size_t)m * LD_F8, SC_XS, lane);
#endif
#if CVT_IN_P0
        {   constexpr int J_E1 = 32 * 128, J_E2 = 32 * 64, NEI = NE * J_E1 + NE * J_E2;
            auto dece = [=](int r) -> CvtItem {
                if (r < NE * J_E1) { const int e = r / J_E1, q = r % J_E1, k0 = 64 * (q / 128), n0 = 32 * (q % 128);
                    const int nn = n0 & 2047, drow = (nn >> 7) * 256 + (n0 >= 2048 ? 128 : 0) + (nn & 127);
                    return CvtItem{w1 + (size_t)e * DM * 4096 + (size_t)k0 * 4096 + n0, (unsigned char*)Wt_1 + ((size_t)e * 4096 + drow) * LD_F8 + k0, 4096, LD_F8}; }
                r -= NE * J_E1; const int e = r / J_E2, q = r % J_E2, k0 = 64 * (q / 64), n0 = 32 * (q % 64);
                return CvtItem{w2 + (size_t)e * FF * DM + (size_t)k0 * 2048 + n0, (unsigned char*)Wt_2 + ((size_t)e * 2048 + n0) * LD_F8 + k0, 2048, LD_F8}; };
            cvt_run<true>(dece, gw, NGW, NEI / NGW, scr, lane, SC_W); }
#endif
#if P4_FP8
        {   unsigned char* Wo8 = ws + WS_WO8; auto deco = [=](int r) -> CvtItem { const int k0 = 64 * (r / 64), n0 = 32 * (r % 64); return CvtItem{w_out + (size_t)k0 * 2048 + n0, Wo8 + (size_t)n0 * LD_F8 + k0, 2048, LD_F8}; };
            cvt_run<true>(deco, gw, NGW, (2048 - gw + NGW - 1) / NGW, scr, lane, SC_W); }
#endif
        for (int m = gw; m < T; m += NGW) rms_row_to_bf16(x + (size_t)m * DM, g_mix, Hb + (size_t)m * LD_D, H8 + (size_t)m * LD_F8, SC_XS, lane);
        for (int m = gw; m < NB * ML; m += NGW) rms_row_to_bf16(mem + (size_t)m * DM, g_mem, MemN + (size_t)m * LD_D, nullptr, 1.f, lane);
    }
    if (IN(0) && IN(1)) {
        pg8::GateOrder Sa; Sa.S.init(T, 256 * NT_BF, G, bx); Sa.mask = BF_TILES; order_fill_tab(Sa, tile0 + 128);
        pg8::GateOrder Sb; Sb.S.init(T, 256 * NT_F8, G, bx); Sb.mask = F8_TILES; order_fill_tab(Sb, tile0 + 192); }
    SEAM(0);
    if (IN(1)) {
        {   pg8::Gemm g{Hb, Wt_in, T, INW, DM, 0, 0, LD_D, LD_D}; pg8::MoeTabOrder S{(const LAS int*)tile0 + 128};
            pg8::EpiProjQ E{Proj, b_gate};
            pg8::gemm_phase<pg8::EpiProjQ, pg8::MoeTabOrder, true, true>(lds, g, S, E); }
        {
            pg8::Gemm g{(const bf16*)H8, (const bf16*)Wg8, T, INW, DM / 2, SC_XS_BYTE, SC_W_BYTE, LD_F8 / 2, LD_F8 / 2}; pg8::MoeTabOrder S{(const LAS int*)tile0 + 192};
            pg8::EpiProj E{Proj, b_gate};
            pg8::gemm_phase<pg8::EpiProj, pg8::MoeTabOrder, true, true, true, true>(lds, g, S, E); }
    }
    SEAM(1);
    if (IN(2)) {
        if (MK_ATT & 8) {   pg8::Gemm g{MemN, Wt_kv, NB * ML, 2048, DM, 0, 0, LD_D, LD_D}; pg8::KvOrder S{bx};
            pg8::EpiBf16<0> E{KV, LD_D, nullptr, 0, 0, 1.f};
            pg8::gemm_phase<pg8::EpiBf16<0>, pg8::KvOrder, false, true>(lds, g, S, E);
            if (bx < 16) {
                asm volatile("s_waitcnt vmcnt(0)" ::: "memory"); __syncthreads();
                if (tid == 0) { __builtin_amdgcn_fence(__ATOMIC_RELEASE, "agent"); asm volatile("s_waitcnt vmcnt(0)" ::: "memory"); __hip_atomic_fetch_add(ctl + CW_KVDONE, 1u, RLX_AGENT); }
            }
        }
        float s1 = 0.f, s2 = 0.f;
        for (int i = 0; i < 64; ++i) { s1 += lq1[i] * lk1[i]; s2 += lq2[i] * lk2[i]; }
        const att::AttnIO io{Proj, KV, Yb, rel_bias, subg, expf(s1) - expf(s2) + 0.2f};
        const att::CvCtx cvx{w1, w2, (unsigned char*)Wt_1, (unsigned char*)Wt_2, SC_W};
        if (MK_ATT & 1) for (;;) { int qx = 0; int idx = dequeue_diff(ctl + CW_QDX, bx, dq_slot, qx);
            if (idx < 0) break;
            const int qb = 63 - (idx & 63), bh = 2 * qx + (idx >> 6); idx += 128 * qx;
            constexpr int T_E1 = 16 * 32, T_E2 = 16 * 16, CHT = (NE * T_E1 + NE * T_E2) / 1024;
            auto dect = [=](int t) -> CvtTile {
                if (t < NE * T_E1) { const int e = t / T_E1, q = t % T_E1, k0 = 128 * (q / 32), n0 = 128 * (q % 32); const int nn = n0 & 2047, drow = (nn >> 7) * 256 + (n0 >= 2048 ? 128 : 0);
                    return CvtTile{w1 + (size_t)e * DM * 4096 + (size_t)k0 * 4096 + n0, (unsigned char*)Wt_1 + ((size_t)e * 4096 + drow) * LD_F8 + k0, 4096}; }
                const int t2 = t - NE * T_E1, e = t2 / T_E2, q = t2 % T_E2, k0 = 128 * (q / 16), n0 = 128 * (q % 16);
                return CvtTile{w2 + (size_t)e * FF * DM + (size_t)k0 * 2048 + n0, (unsigned char*)Wt_2 + ((size_t)e * 2048 + n0) * LD_F8 + k0, 2048}; };
            const int nA = 6 * ((bx >> 3) & 3);
            __syncthreads();
            cvt_wg(dect, idx * CHT, nA, lds, wave, lane, SC_W);
            att::attn_unit_diff2(io, bh >> 3, bh & 7, qb, (LAS char*)lds);
            __syncthreads();
            cvt_wg(dect, idx * CHT + nA, CHT - nA, lds, wave, lane, SC_W);
        }
#ifdef PROBE_DIFF_TWICE
        for (;;) { int idx = -1, qx = 0;
            for (int s = 0; s < 8 && idx < 0; ++s) { qx = (bx + s) & 7; const int li = dequeue(ctl + CW_QDX + 128 + 16 * qx, dq_slot); if (li < 128) idx = li; }
            if (idx < 0) break;
            const int qb = 63 - (idx & 63), bh = 2 * qx + (idx >> 6);
            att::attn_unit_diff2(io, bh >> 3, bh & 7, qb, (LAS char*)lds); }
#endif
        if (MK_ATT & 2) for (;;) { const int idx = dequeue(ctl + CW_QSB, dq_slot); if (idx >= 16 * 32) break;
            const int qb = 31 - idx / 16, bh = idx % 16; att::attn_unit<att::SB>(io, bh >> 3, bh & 7, qb, 0, (LAS char*)lds); }
        if (tid == 0) { unsigned sp = 0; while (__hip_atomic_load(ctl + CW_KVDONE, RLX_AGENT) < 16u) { __builtin_amdgcn_s_sleep(2); if (++sp > (1u << 22)) break; }
            __builtin_amdgcn_fence(__ATOMIC_ACQUIRE, "agent"); asm volatile("s_waitcnt vmcnt(0)" ::: "memory"); }
        __syncthreads();
        if (MK_ATT & 4) for (;;) { const int idx = dequeue(ctl + CW_QMEM, dq_slot); if (idx >= 2 * 4 * 2 * 32) break;
            const int qb = idx & 31, vh = (idx >> 5) & 1, hd = (idx >> 6) & 3, b = idx >> 8; att::attn_unit<att::MEM>(io, b, hd, qb, vh, (LAS char*)lds); }
        __syncthreads();
#ifdef PROBE_SBMEM_TWICE
        for (;;) { const int idx = dequeue(ctl + CW_QSB + 16, dq_slot); if (idx >= 16 * 32) break;
            const int qb = 31 - idx / 16, bh = idx % 16; att::attn_unit<att::SB>(io, bh >> 3, bh & 7, qb, 0, (LAS char*)lds); }
        for (;;) { const int idx = dequeue(ctl + CW_QMEM + 16, dq_slot); if (idx >= 2 * 4 * 2 * 32) break;
            const int qb = idx & 31, vh = (idx >> 5) & 1, hd = (idx >> 6) & 3, b = idx >> 8; att::attn_unit<att::MEM>(io, b, hd, qb, vh, (LAS char*)lds); }
        __syncthreads();
#endif
    }
    if (IN(2) && IN(3)) { pg8::StaticOrder Sa; Sa.init(T, DM, G, bx); order_fill_tab(Sa, tile0 + 128); }
    SEAM(2);
    if (IN(3)) {
        pg8::Gemm g{Yb, Wt_br, T, DM, 3072, 0, 0, LD_Y, LD_Y}; pg8::MoeTabOrder S{(const LAS int*)tile0 + 128};
#if P4_FP8
        pg8::EpiMerged8 E{Merged, Proj + 7168};
        pg8::gemm_phase<pg8::EpiMerged8, pg8::StaticOrder, true, true>(lds, g, S, E);
#else
        pg8::EpiMerged E{Merged, Proj + 7168};
        pg8::gemm_phase<pg8::EpiMerged, pg8::MoeTabOrder, true, true>(lds, g, S, E);
#endif
#if defined(PROBE_REP) && (PROBE_REP == 34 || PROBE_REP == 3)
        __syncthreads(); pg8::gemm_phase<pg8::EpiMerged, pg8::StaticOrder, true, true>(lds, g, S, E);
#endif
    }
    SEAM(3);
    if (IN(4)) {
#if P4_FP8
        pg8::Gemm g{Merged, (const bf16*)(ws + WS_WO8), T, DM, DM / 2, 0x7b7b7b7b, SC_W_BYTE, LD_F8 / 2, LD_F8 / 2}; pg8::StaticOrder S; S.init(T, DM, G, bx);
        pg8::EpiResid E{x, X1};
        pg8::gemm_phase<pg8::EpiResid, pg8::StaticOrder, true, true, true>(lds, g, S, E);
#else
        pg8::Gemm g{Merged, Wt_out, T, DM, DM, 0, 0, LD_D, LD_D}; pg8::MoeTabOrder S{(const LAS int*)tile0 + 128};
        pg8::EpiResid E{x, X1};
#ifndef P4_STAGGER
#define P4_STAGGER 2
#endif
        if ((bx >> 3) & 1) { for (int i = 0; i < P4_STAGGER; ++i) __builtin_amdgcn_s_sleep(127); }
        pg8::gemm_phase<pg8::EpiResid, pg8::MoeTabOrder, true, true>(lds, g, S, E);
#endif
#if defined(PROBE_REP) && PROBE_REP == 34
        __syncthreads(); pg8::gemm_phase<pg8::EpiResid, pg8::StaticOrder, true, true>(lds, g, S, E);
#endif
    }
    SEAM(4);
    if (IN(5)) {
        const int i32 = lane & 31, kh = lane >> 5, kq = wave & 3, hg = wave >> 2;
        LAS float* part = (LAS float*)lds;
        for (int gb = 2 * vcu; gb < T / 32; gb += 2 * G) {
            const int grp = gb + hg, t0 = grp * 32; const float* xrow = X1 + (size_t)(t0 + i32) * DM + kq * 512 + 16 * kh;
            const float* wrow = w_r + (size_t)(kq * 512 + 16 * kh) * NE + i32; const float* grow = g_ffn + kq * 512 + 16 * kh;
            f32x16 acc = {}; float ss = 0.f;
            f32x4 xa[4], ga[4], xb[4], gb4[4]; float wa[16], wb[16];
#define P5_LOAD(XV, GV, WV, s) do { _Pragma("unroll") for (int q = 0; q < 4; ++q) { XV[q] = __builtin_nontemporal_load((const f32x4*)(xrow + (s) * 32 + 4 * q)); GV[q] = *(const f32x4*)(grow + (s) * 32 + 4 * q); } \
                _Pragma("unroll") for (int q = 0; q < 16; ++q) WV[q] = wrow[(size_t)((s) * 32 + q) * NE]; } while (0)
#define P5_MMA(XV, GV, WV) do { _Pragma("unroll") for (int q = 0; q < 4; ++q) _Pragma("unroll") for (int j = 0; j < 4; ++j) { const float b = XV[q][j]; ss += b * b; \
                acc = __builtin_amdgcn_mfma_f32_32x32x2f32(WV[4 * q + j] * GV[q][j], b, acc, 0, 0, 0); } } while (0)
            P5_LOAD(xa, ga, wa, 0);
#pragma unroll 1
            for (int s = 0; s < 16; s += 2) {
                P5_LOAD(xb, gb4, wb, s + 1);
                P5_MMA(xa, ga, wa);
                if (s + 2 < 16) P5_LOAD(xa, ga, wa, s + 2);
                P5_MMA(xb, gb4, wb);
            }
#undef P5_LOAD
#undef P5_MMA
            __syncthreads();
#pragma unroll
            for (int r = 0; r < 16; ++r) part[(wave * 17 + r) * 64 + lane] = acc[r];
            part[(wave * 17 + 16) * 64 + lane] = ss;
            __syncthreads();
            if (kq == 0 && grp < T / 32) {
#pragma unroll
                for (int r = 0; r < 16; ++r) acc[r] = (part[((wave + 0) * 17 + r) * 64 + lane] + part[((wave + 1) * 17 + r) * 64 + lane]) + (part[((wave + 2) * 17 + r) * 64 + lane] + part[((wave + 3) * 17 + r) * 64 + lane]);
                ss = (part[((wave + 0) * 17 + 16) * 64 + lane] + part[((wave + 1) * 17 + 16) * 64 + lane]) + (part[((wave + 2) * 17 + 16) * 64 + lane] + part[((wave + 3) * 17 + 16) * 64 + lane]);
                ss = att::swap_sum(ss);
                const float rstd = rsqrtf(ss * (1.f / DM) + NORM_EPS);
                float v[16];
#pragma unroll
                for (int r = 0; r < 16; ++r) v[r] = acc[r] * rstd + b_r[att::crow(r, kh)];
                float cv[8]; int ci[8];
#pragma unroll
                for (int k = 0; k < 4; ++k) { float best = -3.0e38f; int idx = 64;
#pragma unroll
                    for (int r = 0; r < 16; ++r) { const int e = att::crow(r, kh); const bool better = v[r] > best || (v[r] == best && e < idx); best = better ? v[r] : best; idx = better ? e : idx; }
#pragma unroll
                    for (int r = 0; r < 16; ++r) if (att::crow(r, kh) == idx) v[r] = -3.0e38f;
                    cv[k] = best; ci[k] = idx; }
#pragma unroll
                for (int k = 0; k < 4; ++k) { cv[4 + k] = att::other_half(cv[k]); ci[4 + k] = __float_as_int(att::other_half(__int_as_float(ci[k]))); }
                float tv[4]; int ti[4];
#pragma unroll
                for (int k = 0; k < 4; ++k) { float best = -3.0e38f; int idx = 64;
#pragma unroll
                    for (int c = 0; c < 8; ++c) { const bool better = cv[c] > best || (cv[c] == best && ci[c] < idx); best = better ? cv[c] : best; idx = better ? ci[c] : idx; }
#pragma unroll
                    for (int c = 0; c < 8; ++c) if (ci[c] == idx) cv[c] = -3.0e38f;
                    tv[k] = best; ti[k] = idx; }
                const float e1 = expf(tv[1] - tv[0]), e2 = expf(tv[2] - tv[0]), e3 = expf(tv[3] - tv[0]), inv = 1.0f / (1.0f + e1 + e2 + e3);
                if (kh == 0) { const int t = t0 + i32; r_rstd[t] = rstd;
                    r_topg[t * 4 + 0] = inv; r_topg[t * 4 + 1] = e1 * inv; r_topg[t * 4 + 2] = e2 * inv; r_topg[t * 4 + 3] = e3 * inv;
#pragma unroll
                    for (int k = 0; k < 4; ++k) { r_topi[t * 4 + k] = ti[k]; r_slot[t * 4 + k] = (int)__hip_atomic_fetch_add(ctl + CW_CNT + ti[k], 1u, RLX_AGENT); } }
            }
        }
    }
    SEAM(5);
    if (IN(6)) {
        build_tile0(ctl + CW_CNT, tile0);
#if defined(PROBE_REP) && PROBE_REP == 69
        for (int rep = 0; rep < 2; ++rep)
#endif
        for (int t = gw; t < T; t += NGW) {
            const GAS f32x4* xr = (const GAS f32x4*)(X1 + (size_t)t * DM) + lane; const GAS f32x4* gr = (const GAS f32x4*)g_ffn + lane; const float rstd = r_rstd[t];
            unsigned w[8];
#pragma unroll
            for (int j = 0; j < 8; ++j) { const f32x4 v = __builtin_nontemporal_load(xr + 64 * j), gg = gr[64 * j]; const float s = rstd * SC_XS; w[j] = pk4_fp8(v.x * s * gg.x, v.y * s * gg.y, v.z * s * gg.z, v.w * s * gg.w); }
#pragma unroll
            for (int k = 0; k < 4; ++k) { const int e = r_topi[t * 4 + k], dest = tile0[e] * 256 + r_slot[t * 4 + k];
                GAS unsigned* o4 = (GAS unsigned*)((unsigned char*)XS + (size_t)dest * LD_F8) + lane;
#pragma unroll
                for (int j = 0; j < 8; ++j) __builtin_nontemporal_store(w[j], o4 + 64 * j);
                if (lane == 0) r_pos[t * 4 + k] = dest; }
        }
    }
    if (IN(6) && IN(7)) moe_fill_tab(tile0, tile0 + 128, 16, G, vcu);
    SEAM(6);
    if (IN(7)) {
        pg8::Gemm g{XS, Wt_1, P, NE * 4096, DM / 2, SC_XS_BYTE, SC_W_BYTE, LD_F8 / 2, LD_F8 / 2}; pg8::MoeTabOrder S{(const LAS int*)tile0 + 128};
        pg8::EpiSwiglu E{(unsigned char*)ACT, b1};
        pg8::gemm_phase<pg8::EpiSwiglu, pg8::MoeTabOrder, true, true, true, true>(lds, g, S, E);
#if defined(PROBE_REP) && PROBE_REP == 7
        __syncthreads(); pg8::gemm_phase<pg8::EpiSwiglu, pg8::MoeOrder, true, true, true>(lds, g, S, E);
#endif
    }
    if (IN(7) && IN(8)) moe_fill_tab(tile0, tile0 + 128, 8, G, vcu);
    SEAM(7);
    if (IN(8)) {
        pg8::Gemm g{ACT, Wt_2, P, NE * 2048, FF / 2, SC_ACT_BYTE, SC_W_BYTE, LD_F8 / 2, LD_F8 / 2}; pg8::MoeTabOrder S{(const LAS int*)tile0 + 128};
        pg8::EpiYs8 E{(unsigned char*)YS, b2};
        pg8::gemm_phase<pg8::EpiYs8, pg8::MoeTabOrder, true, true, true, true>(lds, g, S, E);
#if defined(PROBE_REP) && PROBE_REP == 8
        __syncthreads(); pg8::gemm_phase<pg8::EpiBf16<0>, pg8::MoeOrder, true, true, true>(lds, g, S, E);
#endif
    }
    SEAM(8);
    if (IN(9)) {
#if defined(PROBE_REP) && PROBE_REP == 69
        for (int rep = 0; rep < 2; ++rep)
#endif
        for (int t = gw; t < T; t += NGW) {
            const GAS f32x4* xr = (const GAS f32x4*)(X1 + (size_t)t * DM) + lane;
            f32x4 v[8];
#pragma unroll
            for (int j = 0; j < 8; ++j) v[j] = __builtin_nontemporal_load(xr + 64 * j);
#pragma unroll
            for (int k = 0; k < 4; ++k) { const float gk = r_topg[t * 4 + k] * (1.0f / 16.0f); const GAS int* yr = (const GAS int*)((const unsigned char*)YS + (size_t)r_pos[t * 4 + k] * DM) + lane;
#pragma unroll
                for (int j = 0; j < 8; ++j) { const int y = __builtin_nontemporal_load(yr + 64 * j); typedef float f32x2_t __attribute__((ext_vector_type(2)));
                    const f32x2_t lo = __builtin_amdgcn_cvt_pk_f32_fp8(y, false), hi = __builtin_amdgcn_cvt_pk_f32_fp8(y, true);
                    v[j].x += gk * lo.x; v[j].y += gk * lo.y; v[j].z += gk * hi.x; v[j].w += gk * hi.y; } }
            float s = 0.f;
#pragma unroll
            for (int j = 0; j < 8; ++j) s += (v[j].x * v[j].x + v[j].y * v[j].y) + (v[j].z * v[j].z + v[j].w * v[j].w);
            const float rstd = rsqrtf(wave_sum(s) * (1.f / DM) + NORM_EPS);
            GAS f32x4* orow = (GAS f32x4*)(args.out + (size_t)t * DM) + lane; const GAS f32x4* gr = (const GAS f32x4*)g_final + lane;
#pragma unroll
            for (int j = 0; j < 8; ++j) { const f32x4 gg = gr[64 * j]; __builtin_nontemporal_store((f32x4){v[j].x * rstd * gg.x, v[j].y * rstd * gg.y, v[j].z * rstd * gg.z, v[j].w * rstd * gg.w}, orow + 64 * j); }
        }
    }
#undef IN
#undef SEAM
}

extern "C" void kernel_launch(void* const* d_in, const int* in_sizes, int n_in, void* d_out, int out_size, void* d_ws, size_t ws_size, hipStream_t stream) {
    static int grid = 0;
    if (grid == 0) {
        if (n_in != 25 || out_size != T * DM || ws_size < WS_END) { fprintf(stderr, "kernel_launch: expected 25 inputs, out %d, ws >= %zu; got %d, %d, %zu\n", T * DM, (size_t)WS_END, n_in, out_size, ws_size); grid = -1; return; }
        int dev = 0, cus = 0, per_cu = 0;
        if (hipGetDevice(&dev) != hipSuccess || hipDeviceGetAttribute(&cus, hipDeviceAttributeMultiprocessorCount, dev) != hipSuccess) { grid = -1; return; }
        if (hipFuncSetAttribute((const void*)fwd_kernel, hipFuncAttributeMaxDynamicSharedMemorySize, LDS_BYTES) != hipSuccess) { fprintf(stderr, "kernel_launch: hipFuncSetAttribute failed\n"); grid = -1; return; }
        if (hipOccupancyMaxActiveBlocksPerMultiprocessor(&per_cu, (const void*)fwd_kernel, NWAVES * 64, LDS_BYTES) != hipSuccess || per_cu < 1) { fprintf(stderr, "kernel_launch: occupancy query reports %d blocks per CU\n", per_cu); }
        (void)hipGetLastError();
        grid = cus;
    }
    if (grid < 0) return;
    if (hipMemsetAsync((char*)d_ws + WS_CTL, 0, CTL_ZERO_BYTES, stream) != hipSuccess) { fprintf(stderr, "kernel_launch: memset failed\n"); return; }
    Args a{};
    for (int i = 0; i < 25; ++i) a.in[i] = (const float*)d_in[i];
    a.out = (float*)d_out; a.ws = (unsigned char*)d_ws; a.pad = 0;
#ifndef MK_CUTS
#define MK_CUTS {0, N_PHASES}
#endif
    const int cuts[] = MK_CUTS; const int nl = (int)(sizeof(cuts) / sizeof(int)) - 1;
    for (int li = 0; li < nl; ++li) {
        a.ph_lo = cuts[li]; a.ph_hi = cuts[li + 1]; a.li = li;
        hipLaunchKernelGGL(fwd_kernel, dim3(grid), dim3(NWAVES * 64), LDS_BYTES, stream, a);
        const hipError_t le = hipPeekAtLastError();
        if (le != hipSuccess) { fprintf(stderr, "kernel_launch: launch %d failed: %s\n", li, hipGetErrorName(le)); break; }
    }
}
```

```cpp
#include <hip/hip_runtime.h>
#include <cstdio>
#include <cstdint>
constexpr int LD_D = 2048 + 64;
constexpr int LD_Y = 3072 + 64;
constexpr int LD_P = 13312 + 64;
constexpr int LD_F8 = 2048 + 128;
namespace pg8 {
#define PG8_LAS __attribute__((address_space(3)))
typedef unsigned short bf16_t;
typedef short bf16x8 __attribute__((ext_vector_type(8)));
typedef float f32x4 __attribute__((ext_vector_type(4)));
typedef unsigned u32x4 __attribute__((ext_vector_type(4)));
constexpr int BM = 256, BK = 64, HALF = 128, HTB = HALF * BK * 2  , STAGE_BYTES = 8 * HTB, NXCD = 8, WGM = 8;

__host__ __device__ __forceinline__ int lds_byte(int r, int c) { const int st = (r >> 4) * 2 + (c >> 5), rr = r & 15, cc = c & 31, ob = rr * 64 + cc * 2; return st * 1024 + (ob ^ (((ob >> 9) & 1) << 5)); }
__host__ __device__ __forceinline__ void stage_rc(int b, int& R, int& C) { const int st = b / 1024, sb = b % 1024, swz = sb ^ (((sb >> 9) & 1) << 5); R = (st >> 1) * 16 + swz / 64; C = (st & 1) * 32 + (swz % 64) / 2; }
__host__ __device__ __forceinline__ int perm32(int rho) { const int n = rho >> 4, i = rho & 15; return 8 * (i >> 2) + 4 * n + (i & 3); }

typedef int i32x8 __attribute__((ext_vector_type(8))); typedef int i32x4 __attribute__((ext_vector_type(4)));
__device__ __forceinline__ i32x8 pg8_cat(bf16x8 lo, bf16x8 hi) { const i32x4 a = __builtin_bit_cast(i32x4, lo), b = __builtin_bit_cast(i32x4, hi); return __builtin_shufflevector(a, b, 0, 1, 2, 3, 4, 5, 6, 7); }
struct Unit { int pm, pn; };
struct Gemm { const bf16_t* A; const bf16_t* Bt; int M, N, K; int sa, sb; int lda, ldb; };

struct StaticOrder {
    int nM, nN, nwg, G, c;
    __host__ __device__ void init(int M, int N, int G_, int c_) { nM = M / BM; nN = N / BM; nwg = nM * nN; G = G_; c = c_; }
    __host__ __device__ bool next(int i, Unit& u) const {
        const long L = (long)i * G + c; if (L >= nwg) return false;
        int wgid = (int)L; { const int q = nwg / NXCD, r = nwg % NXCD, xcd = wgid % NXCD, off = wgid / NXCD; wgid = (xcd < r ? xcd * (q + 1) : r * (q + 1) + (xcd - r) * q) + off; }
        const int nig = WGM * nN, gid = wgid / nig, fm = gid * WGM, gsz = (nM - fm) < WGM ? (nM - fm) : WGM;
        u.pm = fm + ((wgid % nig) % gsz); u.pn = (wgid % nig) / gsz; return true;
    }
    __device__ __forceinline__ void a_ready(const Unit&) const {}
    __device__ __forceinline__ void done(const Unit&) const {}
};

__device__ __forceinline__ unsigned cvt_pk_bf16(float lo, float hi) { unsigned r; asm volatile("v_cvt_pk_bf16_f32 %0, %1, %2" : "=v"(r) : "v"(lo), "v"(hi)); return r; }
typedef float f32x2 __attribute__((ext_vector_type(2)));
__device__ __forceinline__ f32x2 gelu_pk(f32x2 v) {
    const f32x2 av = __builtin_elementwise_abs(v), d = av * 0.2316418882f + 1.0f;
    f32x2 t; t.x = __builtin_amdgcn_rcpf(d.x); t.y = __builtin_amdgcn_rcpf(d.y);
    f32x2 q = t * 0.5307027145f + (-0.7265760135f); q = q * t + 0.7107068705f; q = q * t + (-0.142248368f); q = q * t + 0.127414796f; q = q * t;
    const f32x2 s = (v * v) * (-0.72134752044f);
    f32x2 e; e.x = __builtin_amdgcn_exp2f(s.x); e.y = __builtin_amdgcn_exp2f(s.y);
    const f32x2 m = v * (q * e), r = v - m;
    f32x2 o; o.x = v.x < 0.f ? m.x : r.x; o.y = v.y < 0.f ? m.y : r.y; return o;
}

template <int ACT  > struct EpiBf16 {
    static constexpr bool PERM = true, AFTER_DRAIN = false, MIDK = false; static_assert(ACT == 0 || ACT == 1, "EpiBf16: ACT is 0 (none) or 1 (gelu_pk)");
    bf16_t* O; int ldc; const float* bias; int split_cols; size_t split_stride; float scale0;
    struct Pre {}; __device__ __forceinline__ Pre prefetch(const Unit&, int, int, int, int) const { return Pre{}; }
    __device__ __forceinline__ void operator()(const f32x4 (&acc)[2][2][4][2], const Unit& u, int wr, int wc, int fr, int fq, const Pre&) const {
        const int row0 = u.pm * BM + wr * 64 + fr; int colt = u.pn * BM; bf16_t* base = O;
        float sc = 1.f; if (split_cols) { const int t = colt / split_cols; base += (size_t)t * split_stride; colt -= t * split_cols; if (t == 0) sc = scale0; }
        const int col0 = colt + wc * 32 + 8 * fq, bcol0 = u.pn * BM + wc * 32 + 8 * fq;
        f32x4 bv[2][2];
#pragma unroll
        for (int bj = 0; bj < 2; ++bj)
#pragma unroll
            for (int n = 0; n < 2; ++n) bv[bj][n] = bias ? *(const f32x4*)(bias + bcol0 + bj * HALF + 4 * n) : (f32x4){0.f, 0.f, 0.f, 0.f};
#pragma unroll
        for (int ai = 0; ai < 2; ++ai)
#pragma unroll
            for (int m = 0; m < 4; ++m) { bf16_t* rowp = base + (size_t)(row0 + ai * HALF + m * 16) * ldc + col0;
#pragma unroll
                for (int bj = 0; bj < 2; ++bj) { f32x4 v0 = acc[ai][bj][m][0] + bv[bj][0], v1 = acc[ai][bj][m][1] + bv[bj][1];
                    if (ACT == 1) { f32x2 a = gelu_pk((f32x2){v0[0], v0[1]}), b = gelu_pk((f32x2){v0[2], v0[3]}), c = gelu_pk((f32x2){v1[0], v1[1]}), d = gelu_pk((f32x2){v1[2], v1[3]});
                        v0 = (f32x4){a.x, a.y, b.x, b.y}; v1 = (f32x4){c.x, c.y, d.x, d.y}; }
                    v0 = v0 * sc; v1 = v1 * sc; u32x4 w; w.x = cvt_pk_bf16(v0[0], v0[1]); w.y = cvt_pk_bf16(v0[2], v0[3]); w.z = cvt_pk_bf16(v1[0], v1[1]); w.w = cvt_pk_bf16(v1[2], v1[3]);
                    *(u32x4*)(rowp + bj * HALF) = w; } }
    }
};
constexpr int INW_ = 13312, CG_ = 7168;
constexpr float LOG2E_ = 1.4426950408889634f;
__device__ __forceinline__ void ld_bf16x8(const bf16_t* p, float (&f)[8]) {
    const u32x4 w = *(const u32x4*)p;
    f[0] = __uint_as_float(w.x << 16); f[1] = __uint_as_float(w.x & 0xffff0000u); f[2] = __uint_as_float(w.y << 16); f[3] = __uint_as_float(w.y & 0xffff0000u);
    f[4] = __uint_as_float(w.z << 16); f[5] = __uint_as_float(w.z & 0xffff0000u); f[6] = __uint_as_float(w.w << 16); f[7] = __uint_as_float(w.w & 0xffff0000u);
}
template <bool GATES> struct EpiProjT {
    static constexpr bool PERM = true, AFTER_DRAIN = false, MIDK = false;
    bf16_t* O; const float* b_gate;
    struct Pre { f32x4 bv[GATES ? 2 : 1][2]; };
    __device__ __forceinline__ Pre prefetch(const Unit& u, int wr, int wc, int fr, int fq) const {
        Pre p; const int col0 = u.pn * BM + wc * 32 + 8 * fq; const bool gate = GATES && u.pn >= CG_ / BM;
#pragma unroll
        for (int bj = 0; bj < (GATES ? 2 : 1); ++bj)
#pragma unroll
            for (int n = 0; n < 2; ++n) p.bv[bj][n] = gate ? *(const f32x4*)(b_gate + (col0 - CG_) + bj * HALF + 4 * n) : (f32x4){0.f, 0.f, 0.f, 0.f};
        return p;
    }
    __device__ __forceinline__ void operator()(const f32x4 (&acc)[2][2][4][2], const Unit& u, int wr, int wc, int fr, int fq, const Pre& pre) const {
        const int row0 = u.pm * BM + wr * 64 + fr, col0 = u.pn * BM + wc * 32 + 8 * fq;
        const bool gate = GATES && u.pn >= CG_ / BM;
        float sc = 1.f;
        if (u.pn < 4) sc = 0.125f * LOG2E_; else if (u.pn >= 12 && u.pn < 16) sc = 0.08838834764831845f * LOG2E_; else if (u.pn >= 24 && u.pn < 28) sc = 0.0625f * LOG2E_;
#pragma unroll
        for (int ai = 0; ai < 2; ++ai)
#pragma unroll
            for (int m = 0; m < 4; ++m) { bf16_t* rowp = O + (size_t)(row0 + ai * HALF + m * 16) * LD_P + col0;
#pragma unroll
                for (int bj = 0; bj < 2; ++bj) { f32x4 v0 = acc[ai][bj][m][0], v1 = acc[ai][bj][m][1];
                    if (gate) { v0 = v0 + pre.bv[GATES ? bj : 0][0]; v1 = v1 + pre.bv[GATES ? bj : 0][1];
#pragma unroll
                        for (int j = 0; j < 4; ++j) { v0[j] = __builtin_amdgcn_rcpf(1.0f + __builtin_amdgcn_exp2f(-LOG2E_ * v0[j])); v1[j] = __builtin_amdgcn_rcpf(1.0f + __builtin_amdgcn_exp2f(-LOG2E_ * v1[j])); } }
                    else { v0 = v0 * sc; v1 = v1 * sc; }
                    u32x4 w; w.x = cvt_pk_bf16(v0[0], v0[1]); w.y = cvt_pk_bf16(v0[2], v0[3]); w.z = cvt_pk_bf16(v1[0], v1[1]); w.w = cvt_pk_bf16(v1[2], v1[3]);
                    *(u32x4*)(rowp + bj * HALF) = w; } }
    }
};
typedef EpiProjT<true> EpiProj; typedef EpiProjT<false> EpiProjQ;

template <bool OUT8> struct EpiMergedT {
    static constexpr bool PERM = true, AFTER_DRAIN = false, MIDK = true; static constexpr int MID0 = 16, MID1 = 32;
    bf16_t* O; const bf16_t* gates;
    __device__ __forceinline__ void mid(f32x4 (&acc)[2][2][4][2], const Unit& u, int t, int wr, int wc, int fr, int fq) const {
        int row0 = u.pm * BM + wr * 64 + fr; asm volatile("" : "+v"(row0));
        const int col0 = u.pn * BM + wc * 32 + 8 * fq; const int gn = (t == MID0) ? 0 : 2048;
        u32x4 gnum[2][2][2], gden[2][2][2];
#define MID_LOAD(q, B) do { _Pragma("unroll") for (int mm = 0; mm < 2; ++mm) { const bf16_t* gp = gates + (size_t)(row0 + ((q) >> 1) * HALF + (2 * ((q) & 1) + mm) * 16) * LD_P + col0 + gn; \
            _Pragma("unroll") for (int bj = 0; bj < 2; ++bj) { gnum[B][mm][bj] = __builtin_nontemporal_load((const u32x4*)(gp + bj * HALF)); gden[B][mm][bj] = __builtin_nontemporal_load((const u32x4*)(gp + 2048 + bj * HALF)); } } asm volatile("" ::: "memory"); } while (0)
#define MID_APPLY(q, B) do { _Pragma("unroll") for (int mm = 0; mm < 2; ++mm) _Pragma("unroll") for (int bj = 0; bj < 2; ++bj) { const u32x4 a = gnum[B][mm][bj], b = gden[B][mm][bj]; \
            const float an[8] = {__uint_as_float(a.x << 16), __uint_as_float(a.x & 0xffff0000u), __uint_as_float(a.y << 16), __uint_as_float(a.y & 0xffff0000u), __uint_as_float(a.z << 16), __uint_as_float(a.z & 0xffff0000u), __uint_as_float(a.w << 16), __uint_as_float(a.w & 0xffff0000u)}; \
            const float bn[8] = {__uint_as_float(b.x << 16), __uint_as_float(b.x & 0xffff0000u), __uint_as_float(b.y << 16), __uint_as_float(b.y & 0xffff0000u), __uint_as_float(b.z << 16), __uint_as_float(b.z & 0xffff0000u), __uint_as_float(b.w << 16), __uint_as_float(b.w & 0xffff0000u)}; \
            _Pragma("unroll") for (int j = 0; j < 4; ++j) { acc[(q) >> 1][bj][2 * ((q) & 1) + mm][0][j] *= an[j] * __builtin_amdgcn_rcpf(fmaxf(bn[j], 1e-30f)); acc[(q) >> 1][bj][2 * ((q) & 1) + mm][1][j] *= an[4 + j] * __builtin_amdgcn_rcpf(fmaxf(bn[4 + j], 1e-30f)); } } \
            asm volatile("" ::: "memory"); } while (0)
        MID_LOAD(0, 0); MID_LOAD(1, 1); MID_APPLY(0, 0); MID_LOAD(2, 0); MID_APPLY(1, 1); MID_LOAD(3, 1); MID_APPLY(2, 0); MID_APPLY(3, 1);
#undef MID_LOAD
#undef MID_APPLY
    }
    struct Pre {}; __device__ __forceinline__ Pre prefetch(const Unit&, int, int, int, int) const { return Pre{}; }
    __device__ __forceinline__ void operator()(const f32x4 (&acc)[2][2][4][2], const Unit& u, int wr, int wc, int fr, int fq, const Pre&) const {
        const int row0 = u.pm * BM + wr * 64 + fr, col0 = u.pn * BM + wc * 32 + 8 * fq;
#pragma unroll
        for (int ai = 0; ai < 2; ++ai)
#pragma unroll
            for (int m = 0; m < 4; ++m) { const size_t r = (size_t)(row0 + ai * HALF + m * 16); const bf16_t* gp = gates + r * LD_P + col0 + 4096; bf16_t* rowp = O + r * LD_D + col0;
#pragma unroll
                for (int bj = 0; bj < 2; ++bj) { float g[8]; ld_bf16x8(gp + bj * HALF, g); const f32x4 v0 = acc[ai][bj][m][0], v1 = acc[ai][bj][m][1];
                    if constexpr (OUT8) { int w0 = 0, w1 = 0;
                        w0 = __builtin_amdgcn_cvt_pk_fp8_f32(__builtin_amdgcn_fmed3f(16.f * v0[0] * g[0], -448.f, 448.f), __builtin_amdgcn_fmed3f(16.f * v0[1] * g[1], -448.f, 448.f), w0, false);
                        w0 = __builtin_amdgcn_cvt_pk_fp8_f32(__builtin_amdgcn_fmed3f(16.f * v0[2] * g[2], -448.f, 448.f), __builtin_amdgcn_fmed3f(16.f * v0[3] * g[3], -448.f, 448.f), w0, true);
                        w1 = __builtin_amdgcn_cvt_pk_fp8_f32(__builtin_amdgcn_fmed3f(16.f * v1[0] * g[4], -448.f, 448.f), __builtin_amdgcn_fmed3f(16.f * v1[1] * g[5], -448.f, 448.f), w1, false);
                        w1 = __builtin_amdgcn_cvt_pk_fp8_f32(__builtin_amdgcn_fmed3f(16.f * v1[2] * g[6], -448.f, 448.f), __builtin_amdgcn_fmed3f(16.f * v1[3] * g[7], -448.f, 448.f), w1, true);
                        typedef int i32x2_t __attribute__((ext_vector_type(2)));
                        *(i32x2_t*)((unsigned char*)O + r * LD_F8 + col0 + bj * HALF) = (i32x2_t){w0, w1}; }
                    else { u32x4 w; w.x = cvt_pk_bf16(v0[0] * g[0], v0[1] * g[1]); w.y = cvt_pk_bf16(v0[2] * g[2], v0[3] * g[3]); w.z = cvt_pk_bf16(v1[0] * g[4], v1[1] * g[5]); w.w = cvt_pk_bf16(v1[2] * g[6], v1[3] * g[7]);
                        *(u32x4*)(rowp + bj * HALF) = w; } } }
    }
};
typedef EpiMergedT<false> EpiMerged; typedef EpiMergedT<true> EpiMerged8;
struct EpiResid {
    static constexpr bool PERM = false, AFTER_DRAIN = false, MIDK = false;
    const float* X; float* O;
    struct Pre {}; __device__ __forceinline__ Pre prefetch(const Unit&, int, int, int, int) const { return Pre{}; }
    __device__ __forceinline__ void operator()(const f32x4 (&acc)[2][2][4][2], const Unit& u, int wr, int wc, int fr, int fq, const Pre&) const {
        const int col0 = u.pn * BM + wc * 32 + 4 * fq;
#pragma unroll
        for (int ai = 0; ai < 2; ++ai)
#pragma unroll
            for (int m = 0; m < 4; ++m) { const size_t off = (size_t)(u.pm * BM + ai * HALF + wr * 64 + m * 16 + fr) * 2048 + col0;
#pragma unroll
                for (int bj = 0; bj < 2; ++bj)
#pragma unroll
                    for (int n = 0; n < 2; ++n) { const f32x4 xv = *(const f32x4*)(X + off + bj * HALF + n * 16); *(f32x4*)(O + off + bj * HALF + n * 16) = xv + acc[ai][bj][m][n]; } }
    }
};
struct EpiSwiglu {
    static constexpr bool PERM = true, AFTER_DRAIN = false, MIDK = false;
    unsigned char* O; const float* b1;
    struct Pre { f32x4 bg[2], bl[2]; };
    __device__ __forceinline__ Pre prefetch(const Unit& u, int wr, int wc, int fr, int fq) const {
        Pre p; const int e = u.pn >> 4, nt = u.pn & 15, col0 = nt * 128 + wc * 32 + 8 * fq;
#pragma unroll
        for (int n = 0; n < 2; ++n) { p.bg[n] = *(const f32x4*)(b1 + (size_t)e * 4096 + col0 + 4 * n); p.bl[n] = *(const f32x4*)(b1 + (size_t)e * 4096 + 2048 + col0 + 4 * n); }
        return p;
    }
    __device__ __forceinline__ void operator()(const f32x4 (&acc)[2][2][4][2], const Unit& u, int wr, int wc, int fr, int fq, const Pre& pre) const {
        const int nt = u.pn & 15, row0 = u.pm * BM + wr * 64 + fr, col0 = nt * 128 + wc * 32 + 8 * fq;
        const f32x4 bg[2] = {pre.bg[0], pre.bg[1]}, bl[2] = {pre.bl[0], pre.bl[1]};
#pragma unroll
        for (int ai = 0; ai < 2; ++ai)
#pragma unroll
            for (int m = 0; m < 4; ++m) { unsigned char* rowp = O + (size_t)(row0 + ai * HALF + m * 16) * LD_F8 + col0; float r[8];
#pragma unroll
                for (int n = 0; n < 2; ++n) { const f32x4 ga = acc[ai][0][m][n], la = acc[ai][1][m][n];
#pragma unroll
                    for (int h = 0; h < 2; ++h) {
                        f32x2 g = (f32x2){ga[2 * h], ga[2 * h + 1]} + (f32x2){bg[n][2 * h], bg[n][2 * h + 1]}, l = (f32x2){la[2 * h], la[2 * h + 1]} + (f32x2){bl[n][2 * h], bl[n][2 * h + 1]};
                        g.x = fminf(g.x, 7.0f); g.y = fminf(g.y, 7.0f); l.x = __builtin_amdgcn_fmed3f(l.x, -7.0f, 7.0f); l.y = __builtin_amdgcn_fmed3f(l.y, -7.0f, 7.0f);
                        f32x2 t = g * (-1.702f * LOG2E_); t.x = __builtin_amdgcn_exp2f(t.x); t.y = __builtin_amdgcn_exp2f(t.y);
                        t = t + 1.0f; t.x = __builtin_amdgcn_rcpf(t.x); t.y = __builtin_amdgcn_rcpf(t.y);
                        const f32x2 o = (g * t) * (l * 4.0f + 4.0f);
                        r[4 * n + 2 * h] = o.x; r[4 * n + 2 * h + 1] = o.y; } }
                int w0 = 0, w1 = 0;
                w0 = __builtin_amdgcn_cvt_pk_fp8_f32(r[0], r[1], w0, false); w0 = __builtin_amdgcn_cvt_pk_fp8_f32(r[2], r[3], w0, true);
                w1 = __builtin_amdgcn_cvt_pk_fp8_f32(r[4], r[5], w1, false); w1 = __builtin_amdgcn_cvt_pk_fp8_f32(r[6], r[7], w1, true);
                typedef int i32x2_t __attribute__((ext_vector_type(2)));
                *(i32x2_t*)rowp = (i32x2_t){w0, w1}; }
    }
};
struct EpiYs8 {
    static constexpr bool PERM = true, AFTER_DRAIN = false, MIDK = false;
    unsigned char* O; const float* b2;
    struct Pre { f32x4 bv[2][2]; };
    __device__ __forceinline__ Pre prefetch(const Unit& u, int wr, int wc, int fr, int fq) const {
        Pre p; const int e = u.pn >> 3, nt = u.pn & 7, col0 = nt * BM + wc * 32 + 8 * fq;
#pragma unroll
        for (int bj = 0; bj < 2; ++bj)
#pragma unroll
            for (int n = 0; n < 2; ++n) p.bv[bj][n] = *(const f32x4*)(b2 + (size_t)e * 2048 + col0 + bj * HALF + 4 * n);
        return p;
    }
    __device__ __forceinline__ void operator()(const f32x4 (&acc)[2][2][4][2], const Unit& u, int wr, int wc, int fr, int fq, const Pre& pre) const {
        const int nt = u.pn & 7, row0 = u.pm * BM + wr * 64 + fr, col0 = nt * BM + wc * 32 + 8 * fq;
        f32x4 bv[2][2];
#pragma unroll
        for (int bj = 0; bj < 2; ++bj)
#pragma unroll
            for (int n = 0; n < 2; ++n) bv[bj][n] = pre.bv[bj][n] * 16.0f;
#pragma unroll
        for (int ai = 0; ai < 2; ++ai)
#pragma unroll
            for (int m = 0; m < 4; ++m) { unsigned char* rowp = O + (size_t)(row0 + ai * HALF + m * 16) * 2048 + col0;
#pragma unroll
                for (int bj = 0; bj < 2; ++bj) { f32x2 v[4];
#pragma unroll
                    for (int n = 0; n < 2; ++n)
#pragma unroll
                        for (int h = 0; h < 2; ++h) { const f32x4 a = acc[ai][bj][m][n]; f32x2 t = (f32x2){a[2 * h], a[2 * h + 1]} * 16.0f + (f32x2){bv[bj][n][2 * h], bv[bj][n][2 * h + 1]};
                            t.x = __builtin_amdgcn_fmed3f(t.x, -448.f, 448.f); t.y = __builtin_amdgcn_fmed3f(t.y, -448.f, 448.f); v[2 * n + h] = t; }
                    int w0 = 0, w1 = 0;
                    w0 = __builtin_amdgcn_cvt_pk_fp8_f32(v[0].x, v[0].y, w0, false); w0 = __builtin_amdgcn_cvt_pk_fp8_f32(v[1].x, v[1].y, w0, true);
                    w1 = __builtin_amdgcn_cvt_pk_fp8_f32(v[2].x, v[2].y, w1, false); w1 = __builtin_amdgcn_cvt_pk_fp8_f32(v[3].x, v[3].y, w1, true);
                    typedef int i32x2_t __attribute__((ext_vector_type(2)));
                    *(i32x2_t*)(rowp + bj * HALF) = (i32x2_t){w0, w1}; } }
    }
};
__host__ __device__ __forceinline__ int nth_bit(unsigned long long mask, int n) { int pos = 0; for (;;) { if (mask & 1ull) { if (n == 0) return pos; --n; } mask >>= 1; ++pos; } }
struct GateOrder {
    StaticOrder S; unsigned long long mask;
    __device__ __forceinline__ bool next(int i, Unit& u) const { if (!S.next(i, u)) return false; u.pn = nth_bit(mask, u.pn); return true; }
    __device__ __forceinline__ void a_ready(const Unit&) const {}
    __device__ __forceinline__ void done(const Unit&) const {}
};
struct KvOrder {
    int c;
    __device__ __forceinline__ bool next(int i, Unit& u) const { if (i > 0 || c >= 16) return false; u.pm = c >> 3; u.pn = c & 7; return true; }
    __device__ __forceinline__ void a_ready(const Unit&) const {}
    __device__ __forceinline__ void done(const Unit&) const {}
};
struct MoeOrder {
    const PG8_LAS int* tile0; int nN, G, c;
    __device__ __forceinline__ bool next(int i, Unit& u) const {
        const int L = i * G + c; const int tot = __builtin_amdgcn_readfirstlane(tile0[32]) * nN; if (L >= tot) return false;
        int e = 0;
#pragma unroll 1
        for (int k = 1; k < 32; ++k) e += (L >= __builtin_amdgcn_readfirstlane(tile0[k]) * nN) ? 1 : 0;
        const int t0 = __builtin_amdgcn_readfirstlane(tile0[e]), me = __builtin_amdgcn_readfirstlane(tile0[e + 1]) - t0, rem = L - t0 * nN;
        u.pm = t0 + rem % me; u.pn = e * nN + rem / me; return true;
    }
    __device__ __forceinline__ void a_ready(const Unit&) const {}
    __device__ __forceinline__ void done(const Unit&) const {}
};
struct MoeTabOrder {
    const PG8_LAS int* tab;
    __device__ __forceinline__ bool next(int i, Unit& u) const {
        const int pm = __builtin_amdgcn_readfirstlane(tab[2 * i]); if (pm < 0) return false;
        u.pm = pm; u.pn = __builtin_amdgcn_readfirstlane(tab[2 * i + 1]); return true; }
    __device__ __forceinline__ void a_ready(const Unit&) const {}
    __device__ __forceinline__ void done(const Unit&) const {}
};
template <class Epi, class Sched, bool ALIGN_EPI = false, bool SP2 = false, bool FP8 = false, bool ZK = false>
__device__ __forceinline__ void gemm_phase(PG8_LAS unsigned char* lds, const Gemm g, const Sched& S, const Epi& E) {
    const int tid = threadIdx.x, wid = __builtin_amdgcn_readfirstlane(tid >> 6), lane = tid & 63, wr = wid >> 2, wc = wid & 3, fr = lane & 15, fq = lane >> 4;
    const int K = g.K, nt = K / BK;
    unsigned voffA[2], voffB[2];
#pragma unroll
    for (int i = 0; i < 2; ++i) { int R, C; stage_rc(tid * 16 + i * 8192, R, C); const int Rb = Epi::PERM ? ((R & ~31) + perm32(R & 31)) : R;
        voffA[i] = (unsigned)(R * g.lda + C) * 2u; voffB[i] = (unsigned)(Rb * g.ldb + C) * 2u; }
    const size_t kstep = (size_t)(BK * 2);
    const size_t hstepA = (size_t)HALF * g.lda * 2, hstepB = (size_t)HALF * g.ldb * 2;
    const size_t tstepA = 2 * hstepA, tstepB = 2 * hstepB;
    const unsigned ldsw = (unsigned)wid * 1024u;
    const int aoff = lds_byte(wr * 64 + fr, fq * 8), boff = lds_byte(wc * 32 + fr, fq * 8);
#define PG8_SA(b, h) (((b) * 2 + (h)) * HTB)
#define PG8_SB(b, h) ((4 + (b) * 2 + (h)) * HTB)
#define PG8_STAGE(bufoff, gbase, voff) do { _Pragma("unroll") for (int _i = 0; _i < 2; ++_i) \
        __builtin_amdgcn_global_load_lds((const unsigned*)((const char*)(gbase) + (voff)[_i]), (PG8_LAS unsigned*)(lds + (bufoff) + ldsw + _i * 8192), 16, 0, 0); } while (0)
#define PG8_LDA(dst, b, h) do { _Pragma("unroll") for (int m = 0; m < 4; ++m) _Pragma("unroll") for (int k = 0; k < 2; ++k) dst[m][k] = *(const PG8_LAS bf16x8*)(lds + PG8_SA(b, h) + aoff + m * 2048 + k * 1024); } while (0)
#define PG8_LDB(dst, b, h) do { _Pragma("unroll") for (int n = 0; n < 2; ++n) _Pragma("unroll") for (int k = 0; k < 2; ++k) dst[n][k] = *(const PG8_LAS bf16x8*)(lds + PG8_SB(b, h) + boff + n * 2048 + k * 1024); } while (0)
#define PG8_MMA(ai, bj, At, Bt) do { __builtin_amdgcn_s_setprio(1); _Pragma("unroll") for (int m = 0; m < 4; ++m) _Pragma("unroll") for (int n = 0; n < 2; ++n) { \
        if constexpr (FP8) { asm volatile("v_mfma_scale_f32_16x16x128_f8f6f4 %0, %1, %2, %0, %3, %4 op_sel_hi:[0,0,0]" : "+v"(acc[ai][bj][m][n]) : "v"(pg8_cat(Bt[n][0], Bt[n][1])), "v"(pg8_cat(At[m][0], At[m][1])), "v"(vsb), "v"(vsa)); } \
        else { _Pragma("unroll") for (int k = 0; k < 2; ++k) acc[ai][bj][m][n] = __builtin_amdgcn_mfma_f32_16x16x32_bf16(Bt[n][k], At[m][k], acc[ai][bj][m][n], 0, 0, 0); } } __builtin_amdgcn_s_setprio(0); } while (0)
#define PG8_MMA0(ai, bj, At, Bt) do { __builtin_amdgcn_s_setprio(1); _Pragma("unroll") for (int m = 0; m < 4; ++m) _Pragma("unroll") for (int n = 0; n < 2; ++n) { \
        if constexpr (FP8) { asm volatile("v_mfma_scale_f32_16x16x128_f8f6f4 %0, %1, %2, 0, %3, %4 op_sel_hi:[0,0,0]" : "=v"(acc[ai][bj][m][n]) : "v"(pg8_cat(Bt[n][0], Bt[n][1])), "v"(pg8_cat(At[m][0], At[m][1])), "v"(vsb), "v"(vsa)); } \
        else { acc[ai][bj][m][n] = __builtin_amdgcn_mfma_f32_16x16x32_bf16(Bt[n][0], At[m][0], (f32x4){0.f, 0.f, 0.f, 0.f}, 0, 0, 0); acc[ai][bj][m][n] = __builtin_amdgcn_mfma_f32_16x16x32_bf16(Bt[n][1], At[m][1], acc[ai][bj][m][n], 0, 0, 0); } } __builtin_amdgcn_s_setprio(0); } while (0)
#define PG8_MMAZ(z, ai, bj, At, Bt) do { if (z) PG8_MMA0(ai, bj, At, Bt); else PG8_MMA(ai, bj, At, Bt); } while (0)
#define PG8_WAIT_V(n) asm volatile("s_waitcnt vmcnt(" #n ")" ::: "memory")
#define PG8_WAIT_L(n) asm volatile("s_waitcnt lgkmcnt(" #n ")" ::: "memory")
#define PG8_BAR __builtin_amdgcn_s_barrier()
#define PG8_SCHED __builtin_amdgcn_sched_barrier(0)
    Unit cur, nxt; int ui = 0;
    if (!S.next(0, cur)) return;
    f32x4 acc[2][2][4][2];
    if constexpr (!(SP2 && FP8 && ZK)) {
#pragma unroll
    for (int a = 0; a < 2; ++a)
#pragma unroll
        for (int b = 0; b < 2; ++b)
#pragma unroll
            for (int m = 0; m < 4; ++m)
#pragma unroll
                for (int n = 0; n < 2; ++n) acc[a][b][m][n] = (f32x4){0.f, 0.f, 0.f, 0.f};
    }
    bf16x8 At[4][2], B0[2][2], B1[2][2];
    typename Epi::Pre pre{};
    int vsa = g.sa, vsb = g.sb; asm volatile("" : "+v"(vsa), "+v"(vsb));
    const char* cA = (const char*)g.A + (size_t)cur.pm * tstepA; const char* cB = (const char*)g.Bt + (size_t)cur.pn * tstepB;
    S.a_ready(cur);
    if constexpr (SP2) {
        PG8_STAGE(PG8_SB(0, 0), cB, voffB); PG8_STAGE(PG8_SB(0, 1), cB + hstepB, voffB); PG8_STAGE(PG8_SA(0, 0), cA, voffA); PG8_STAGE(PG8_SA(0, 1), cA + hstepA, voffA);
        PG8_STAGE(PG8_SB(1, 0), cB + kstep, voffB); PG8_STAGE(PG8_SA(1, 0), cA + kstep, voffA); PG8_STAGE(PG8_SB(1, 1), cB + hstepB + kstep, voffB);
        if (wr == 1) PG8_BAR;
        PG8_WAIT_V(8); PG8_BAR;
        PG8_WAIT_V(6); PG8_BAR;
    } else {
        PG8_STAGE(PG8_SB(0, 0), cB, voffB); PG8_STAGE(PG8_SA(0, 0), cA, voffA); PG8_STAGE(PG8_SB(0, 1), cB + hstepB, voffB); PG8_STAGE(PG8_SA(0, 1), cA + hstepA, voffA);
        if (wr == 1) PG8_BAR;
        PG8_WAIT_V(4); PG8_BAR;
        PG8_STAGE(PG8_SB(1, 0), cB + kstep, voffB); PG8_STAGE(PG8_SA(1, 0), cA + kstep, voffA); PG8_STAGE(PG8_SB(1, 1), cB + hstepB + kstep, voffB);
        PG8_WAIT_V(6); PG8_BAR;
    }
    for (;;) {
        const bool has_next = S.next(ui + 1, nxt);
        const char* nA = has_next ? (const char*)g.A + (size_t)nxt.pm * tstepA : cA; const char* nB = has_next ? (const char*)g.Bt + (size_t)nxt.pn * tstepB : cB;
        for (int t = 0; t < nt; t += 2) {
            if constexpr (Epi::MIDK) { if (t == Epi::MID0 || t == Epi::MID1) E.mid(acc, cur, t, wr, wc, fr, fq); }
            const bool last = (t == nt - 2);
            const char* a1 = cA + (size_t)(t + 1) * kstep;
            const char* a2 = last ? nA : cA + (size_t)(t + 2) * kstep; const char* b2 = last ? nB : cB + (size_t)(t + 2) * kstep;
            const char* a3 = a2 + kstep; const char* b3 = b2 + kstep;
            if (last && has_next) S.a_ready(nxt);
            if (last) pre = E.prefetch(cur, wr, wc, fr, fq);
            if constexpr (SP2) {
            const bool zk = FP8 && ZK && (t == 0);
            PG8_LDB(B0, 0, 0); PG8_LDB(B1, 0, 1); PG8_SCHED; PG8_LDA(At, 0, 0); PG8_STAGE(PG8_SA(1, 1), a1 + hstepA, voffA);
            PG8_WAIT_V(8); PG8_WAIT_L(0); PG8_BAR; PG8_MMAZ(zk, 0, 0, At, B0); PG8_MMAZ(zk, 0, 1, At, B1); PG8_BAR; PG8_SCHED;
            PG8_LDA(At, 0, 1); PG8_STAGE(PG8_SB(0, 0), b2, voffB); PG8_STAGE(PG8_SB(0, 1), b2 + hstepB, voffB); PG8_STAGE(PG8_SA(0, 0), a2, voffA);
            PG8_WAIT_V(8); PG8_WAIT_L(0); PG8_BAR; PG8_MMAZ(zk, 1, 0, At, B0); PG8_MMAZ(zk, 1, 1, At, B1); PG8_BAR; PG8_SCHED;
            PG8_LDB(B0, 1, 0); PG8_LDB(B1, 1, 1); PG8_SCHED; PG8_LDA(At, 1, 0); PG8_STAGE(PG8_SA(0, 1), a2 + hstepA, voffA);
            PG8_WAIT_V(8); PG8_WAIT_L(0); PG8_BAR; PG8_MMA(0, 0, At, B0); PG8_MMA(0, 1, At, B1); PG8_BAR; PG8_SCHED;
            PG8_LDA(At, 1, 1); PG8_STAGE(PG8_SB(1, 0), b3, voffB); PG8_STAGE(PG8_SB(1, 1), b3 + hstepB, voffB); PG8_STAGE(PG8_SA(1, 0), a3, voffA);
            PG8_WAIT_V(8); PG8_WAIT_L(0); PG8_BAR; PG8_MMA(1, 0, At, B0); PG8_MMA(1, 1, At, B1); PG8_BAR; PG8_SCHED;
            } else {
            PG8_LDB(B0, 0, 0); PG8_SCHED; PG8_LDA(At, 0, 0); PG8_STAGE(PG8_SA(1, 1), a1 + hstepA, voffA);
            PG8_WAIT_L(8); PG8_BAR; PG8_WAIT_L(0); PG8_MMA(0, 0, At, B0); PG8_BAR; PG8_SCHED;
            PG8_LDB(B1, 0, 1); PG8_STAGE(PG8_SB(0, 0), b2, voffB);
            PG8_BAR; PG8_WAIT_L(0); PG8_MMA(0, 1, At, B1); PG8_BAR;
            PG8_LDA(At, 0, 1); PG8_STAGE(PG8_SA(0, 0), a2, voffA);
            PG8_BAR; PG8_WAIT_L(0); PG8_MMA(1, 0, At, B0); PG8_BAR; PG8_SCHED;
            PG8_STAGE(PG8_SB(0, 1), b2 + hstepB, voffB);
            PG8_WAIT_V(6); PG8_BAR; PG8_MMA(1, 1, At, B1); PG8_BAR;
            PG8_LDB(B0, 1, 0); PG8_SCHED; PG8_LDA(At, 1, 0); PG8_STAGE(PG8_SA(0, 1), a2 + hstepA, voffA);
            PG8_WAIT_L(8); PG8_BAR; PG8_WAIT_L(0); PG8_MMA(0, 0, At, B0); PG8_BAR; PG8_SCHED;
            PG8_LDB(B1, 1, 1); PG8_STAGE(PG8_SB(1, 0), b3, voffB);
            PG8_BAR; PG8_WAIT_L(0); PG8_MMA(0, 1, At, B1); PG8_BAR;
            PG8_LDA(At, 1, 1); PG8_STAGE(PG8_SA(1, 0), a3, voffA);
            PG8_BAR; PG8_WAIT_L(0); PG8_MMA(1, 0, At, B0); PG8_BAR; PG8_SCHED;
            PG8_STAGE(PG8_SB(1, 1), b3 + hstepB, voffB);
            PG8_WAIT_V(6); PG8_BAR; PG8_MMA(1, 1, At, B1); PG8_BAR;
            }
        }
        if constexpr (ALIGN_EPI) { if (wr == 0) PG8_BAR; }
        if constexpr (FP8) asm volatile("s_nop 15\n\ts_nop 15" ::: "memory");
        if constexpr (!Epi::AFTER_DRAIN) { E(acc, cur, wr, wc, fr, fq, pre); S.done(cur); }
#ifdef PROBE_EPI_TWICE
        if constexpr (!Epi::AFTER_DRAIN) { asm volatile("" ::: "memory"); E(acc, cur, wr, wc, fr, fq, pre); }
#endif
        if (!has_next) break;
        if constexpr (!(SP2 && FP8 && ZK)) {
#pragma unroll
        for (int a = 0; a < 2; ++a)
#pragma unroll
            for (int b = 0; b < 2; ++b)
#pragma unroll
                for (int m = 0; m < 4; ++m)
#pragma unroll
                    for (int n = 0; n < 2; ++n) acc[a][b][m][n] = (f32x4){0.f, 0.f, 0.f, 0.f};
        }
        cur = nxt; cA = nA; cB = nB; ++ui;
        if constexpr (ALIGN_EPI) { if (wr == 1) PG8_BAR; }
    }
    PG8_WAIT_V(0);
    if constexpr (!ALIGN_EPI) { if (wr == 0) PG8_BAR; }
    PG8_BAR;
    if constexpr (Epi::AFTER_DRAIN) { E.fused(acc, cur, wr, wc, fr, fq, lds, wid, lane); S.done(cur); }
#undef PG8_SA
#undef PG8_SB
#undef PG8_STAGE
#undef PG8_LDA
#undef PG8_LDB
#undef PG8_MMA
#undef PG8_MMA0
#undef PG8_MMAZ
#undef PG8_WAIT_V
#undef PG8_WAIT_L
#undef PG8_BAR
#undef PG8_SCHED
}
}
namespace att {
#define ALAS __attribute__((address_space(3)))
typedef unsigned short bf16_t;
using bf16x8 = __attribute__((ext_vector_type(8))) short;
using s16x4 = __attribute__((ext_vector_type(4))) short;
using f32x16 = __attribute__((ext_vector_type(16))) float;
using u32x4 = __attribute__((ext_vector_type(4))) unsigned;
constexpr int S_ = 8192, INW = LD_P, YW = LD_Y;
constexpr int C_DQ = 0, C_DK = 1024, C_DV = 2048, C_SQ = 3072, C_SK = 4096, C_SV = 5120, C_MQ = 6144;
constexpr float LOG2E = 1.4426950408889634f;
constexpr float NEG_BIG = -1e30f;
#define SBAR() __builtin_amdgcn_sched_barrier(0)
__device__ __forceinline__ int crow(int r, int hi) { return (r & 3) + 8 * (r >> 2) + 4 * hi; }
__device__ __forceinline__ unsigned cvtpk(float lo, float hi) { unsigned r; asm volatile("v_cvt_pk_bf16_f32 %0, %1, %2" : "=v"(r) : "v"(lo), "v"(hi)); return r; }
template <int PITCH> __device__ __forceinline__ int kswz(int row, int colB) { return row * PITCH + (colB ^ ((row & 7) << 4)); }
template <int NK, int PITCH>
__device__ __forceinline__ void qkt(f32x16& p0, f32x16& p1, const ALAS char* Ks, const bf16x8* qr, int r32, int hi, int cb0) {
    p0 = f32x16{}; p1 = f32x16{};
#pragma unroll
    for (int d0 = 0; d0 < NK; ++d0) { const int cb = cb0 + (d0 * 16 + hi * 8) * 2;
        const bf16x8 b0 = *(const ALAS bf16x8*)(Ks + kswz<PITCH>(r32, cb)), b1 = *(const ALAS bf16x8*)(Ks + kswz<PITCH>(32 + r32, cb));
        p0 = __builtin_amdgcn_mfma_f32_32x32x16_bf16(b0, qr[d0], p0, 0, 0, 0);
        p1 = __builtin_amdgcn_mfma_f32_32x32x16_bf16(b1, qr[d0], p1, 0, 0, 0); }
}
__device__ __forceinline__ int v_st(int k, int c) { const int kk = (k & ~0xC) | ((k & 4) << 1) | ((k & 8) >> 1); return ((kk >> 3) * 4 + (c >> 5)) * 512 + ((kk & 7) * 32 + (c & 31)) * 2; }
__device__ __forceinline__ int v_rd_base(int lane) { return ((lane & 3) << 3) | (((lane >> 2) & 3) << 6) | (((lane >> 4) & 1) << 5) | (((lane >> 5) & 1) << 8); }
constexpr int v_rd_off(int d0, int ks, int half) { return d0 * 512 + ks * 4096 + half * 2048; }
template <int OFF> __device__ __forceinline__ s16x4 tr_read(int vb) { s16x4 r; asm volatile("ds_read_b64_tr_b16 %0, %1 offset:%2" : "=&v"(r) : "v"(vb), "i"(OFF) : "memory"); return r; }
template <int D0> __device__ __forceinline__ void pv_one(f32x16& od, int vb, bf16x8 pa0, bf16x8 pa1, bf16x8 pa2, bf16x8 pa3) {
    const s16x4 l0 = tr_read<v_rd_off(D0, 0, 0)>(vb), h0 = tr_read<v_rd_off(D0, 0, 1)>(vb), l1 = tr_read<v_rd_off(D0, 1, 0)>(vb), h1 = tr_read<v_rd_off(D0, 1, 1)>(vb);
    const s16x4 l2 = tr_read<v_rd_off(D0, 2, 0)>(vb), h2 = tr_read<v_rd_off(D0, 2, 1)>(vb), l3 = tr_read<v_rd_off(D0, 3, 0)>(vb), h3 = tr_read<v_rd_off(D0, 3, 1)>(vb);
    asm volatile("s_waitcnt lgkmcnt(0)" ::: "memory"); SBAR();
#define PK(L, H) (bf16x8){L[0], L[1], L[2], L[3], H[0], H[1], H[2], H[3]}
    od = __builtin_amdgcn_mfma_f32_32x32x16_bf16(pa0, PK(l0, h0), od, 0, 0, 0);
    od = __builtin_amdgcn_mfma_f32_32x32x16_bf16(pa1, PK(l1, h1), od, 0, 0, 0);
    od = __builtin_amdgcn_mfma_f32_32x32x16_bf16(pa2, PK(l2, h2), od, 0, 0, 0);
    od = __builtin_amdgcn_mfma_f32_32x32x16_bf16(pa3, PK(l3, h3), od, 0, 0, 0);
#undef PK
}
#define PV_RD(L, H, D0) do { L[0] = tr_read<v_rd_off(D0, 0, 0)>(vb); H[0] = tr_read<v_rd_off(D0, 0, 1)>(vb); L[1] = tr_read<v_rd_off(D0, 1, 0)>(vb); H[1] = tr_read<v_rd_off(D0, 1, 1)>(vb); \
        L[2] = tr_read<v_rd_off(D0, 2, 0)>(vb); H[2] = tr_read<v_rd_off(D0, 2, 1)>(vb); L[3] = tr_read<v_rd_off(D0, 3, 0)>(vb); H[3] = tr_read<v_rd_off(D0, 3, 1)>(vb); } while (0)
#define PV_PK(L, H, i) (bf16x8){L[i][0], L[i][1], L[i][2], L[i][3], H[i][0], H[i][1], H[i][2], H[i][3]}
#define PV_MM(od, L, H) do { od = __builtin_amdgcn_mfma_f32_32x32x16_bf16(pa0, PV_PK(L, H, 0), od, 0, 0, 0); od = __builtin_amdgcn_mfma_f32_32x32x16_bf16(pa1, PV_PK(L, H, 1), od, 0, 0, 0); \
        od = __builtin_amdgcn_mfma_f32_32x32x16_bf16(pa2, PV_PK(L, H, 2), od, 0, 0, 0); od = __builtin_amdgcn_mfma_f32_32x32x16_bf16(pa3, PV_PK(L, H, 3), od, 0, 0, 0); } while (0)
__device__ __forceinline__ void pv_d0_pipe(f32x16* o, int vb, bf16x8 pa0, bf16x8 pa1, bf16x8 pa2, bf16x8 pa3) {
    s16x4 la[4], ha[4], lb[4], hb[4];
    PV_RD(la, ha, 0); PV_RD(lb, hb, 1);
    asm volatile("s_waitcnt lgkmcnt(8)" ::: "memory"); SBAR(); PV_MM(o[0], la, ha); SBAR();
    PV_RD(la, ha, 2);
    asm volatile("s_waitcnt lgkmcnt(8)" ::: "memory"); SBAR(); PV_MM(o[1], lb, hb); SBAR();
    PV_RD(lb, hb, 3);
    asm volatile("s_waitcnt lgkmcnt(8)" ::: "memory"); SBAR(); PV_MM(o[2], la, ha); SBAR();
    asm volatile("s_waitcnt lgkmcnt(0)" ::: "memory"); SBAR(); PV_MM(o[3], lb, hb);
}
#undef PV_RD
#undef PV_PK
#undef PV_MM
__device__ __forceinline__ void pv_d0(f32x16* o, int vb, bf16x8 pa0, bf16x8 pa1, bf16x8 pa2, bf16x8 pa3) {
    pv_one<0>(o[0], vb, pa0, pa1, pa2, pa3); pv_one<1>(o[1], vb, pa0, pa1, pa2, pa3); pv_one<2>(o[2], vb, pa0, pa1, pa2, pa3); pv_one<3>(o[3], vb, pa0, pa1, pa2, pa3);
}
__device__ __forceinline__ void pack_p(const f32x16& p0, const f32x16& p1, bf16x8& pa0, bf16x8& pa1, bf16x8& pa2, bf16x8& pa3) {
#define PK4(P, BASE, OUT) do { unsigned a0 = cvtpk(P[BASE + 0], P[BASE + 1]), a1 = cvtpk(P[BASE + 2], P[BASE + 3]);   \
    unsigned b0 = cvtpk(P[BASE + 4], P[BASE + 5]), b1 = cvtpk(P[BASE + 6], P[BASE + 7]);                              \
    auto r0 = __builtin_amdgcn_permlane32_swap(a0, b0, false, false); auto r1 = __builtin_amdgcn_permlane32_swap(a1, b1, false, false); \
    u32x4 w = {r0[0], r1[0], r0[1], r1[1]}; OUT = *reinterpret_cast<bf16x8*>(&w); } while (0)
    PK4(p0, 0, pa0); PK4(p0, 8, pa1); PK4(p1, 0, pa2); PK4(p1, 8, pa3);
#undef PK4
}
__device__ __forceinline__ float swap_max(float v) { auto rr = __builtin_amdgcn_permlane32_swap(__float_as_uint(v), __float_as_uint(v), false, false); return fmaxf(__uint_as_float(rr[0]), __uint_as_float(rr[1])); }
__device__ __forceinline__ float swap_sum(float v) { auto rr = __builtin_amdgcn_permlane32_swap(__float_as_uint(v), __float_as_uint(v), false, false); return __uint_as_float(rr[0]) + __uint_as_float(rr[1]); }
__device__ __forceinline__ float other_half(float v) { auto rr = __builtin_amdgcn_permlane32_swap(__float_as_uint(v), __float_as_uint(v), false, false); return (threadIdx.x & 32) ? __uint_as_float(rr[0]) : __uint_as_float(rr[1]); }

__device__ __forceinline__ int t5_bucket(int n) {
    int b = n < 16 ? n : 16;
    b += (n >= 19) + (n >= 21) + (n >= 24) + (n >= 27) + (n >= 31) + (n >= 35) + (n >= 40) + (n >= 46) + (n >= 52) + (n >= 59) + (n >= 67) + (n >= 77) + (n >= 87) + (n >= 99) + (n >= 113);
    return b;
}
constexpr int L_K = 0, L_V = 32768, L_WS = 49152, L_BT = L_WS + 8 * 256, L_FLAG = L_BT + 512, L_XCH = 65536;
enum { DIFF = 0, SB = 1, MEM = 2 };
struct AttnIO { const bf16_t* proj; const bf16_t* kv; bf16_t* y; const float* rel_bias; const float* subg; float lam; };

template <int MODE>
__device__ __forceinline__ void attn_unit(const AttnIO& io, int b, int h, int qb, int vhalf, ALAS char* lds) {
    constexpr int NK = MODE == DIFF ? 4 : (MODE == SB ? 8 : 16);
    constexpr int KCOLS = MODE == MEM ? 256 : 128, PITCH = KCOLS * 2;
    constexpr int UROWS = MODE == DIFF ? 128 : 256;
    const int tid = threadIdx.x, wid = __builtin_amdgcn_readfirstlane(tid >> 6), lane = tid & 63, r32 = lane & 31, hi = lane >> 5;
    const int rg = MODE == DIFF ? (wid & 3) : wid, map = MODE == DIFF ? (wid >> 2) : 0;
    const int q0 = qb * UROWS, qrow = q0 + rg * 32 + r32;
    const ALAS char* K_lds = lds + L_K; const int vb0 = (int)(unsigned)(uintptr_t)(lds + L_V) + v_rd_base(lane);
    ALAS float* wsf = (ALAS float*)(lds + L_WS) + wid * 64;
    ALAS float* btab = (ALAS float*)(lds + L_BT);
    volatile ALAS int* flags = (volatile ALAS int*)(lds + L_FLAG);
    const bf16_t* Qp; const bf16_t* Kg; const bf16_t* Vg; int ldk;
    if (MODE == DIFF) { Qp = io.proj + ((size_t)b * S_ + qrow) * INW + C_DQ + h * 128 + map * 64; Kg = io.proj + (size_t)b * S_ * INW + C_DK + h * 128; Vg = io.proj + (size_t)b * S_ * INW + C_DV + h * 128; ldk = INW; }
    else if (MODE == SB) { Qp = io.proj + ((size_t)b * S_ + qrow) * INW + C_SQ + h * 128; Kg = io.proj + (size_t)b * S_ * INW + C_SK + h * 128; Vg = io.proj + (size_t)b * S_ * INW + C_SV + h * 128; ldk = INW; }
    else { Qp = io.proj + ((size_t)b * S_ + qrow) * INW + C_MQ + h * 256; Kg = io.kv + (size_t)b * 256 * LD_D + h * 256; Vg = io.kv + (size_t)b * 256 * LD_D + 1024 + h * 256 + vhalf * 128; ldk = LD_D; }
    __syncthreads();
    if (MODE == DIFF && tid < 128) { btab[tid] = io.rel_bias[t5_bucket(tid) * 8 + h] * LOG2E; }
    bf16x8 qr[NK];
    if (MODE == DIFF) {
#pragma unroll
        for (int d0 = 0; d0 < NK; ++d0) qr[d0] = *(const bf16x8*)(Qp + d0 * 16 + hi * 8); }
    const int sr = tid >> 4, sc = (tid & 15) * 8;
    const int vst0 = v_st(sr, sc), vst1 = v_st(32 + sr, sc);
    constexpr int NKB = KCOLS / 128;
    bf16x8 ks0[NKB], ks1[NKB], vs0, vs1;
#define SLOAD(k0) do { _Pragma("unroll") for (int cbk = 0; cbk < NKB; ++cbk) { ks0[cbk] = *(const bf16x8*)(Kg + (size_t)((k0) + sr) * ldk + cbk * 128 + sc); ks1[cbk] = *(const bf16x8*)(Kg + (size_t)((k0) + 32 + sr) * ldk + cbk * 128 + sc); } \
        vs0 = *(const bf16x8*)(Vg + (size_t)((k0) + sr) * ldk + sc); vs1 = *(const bf16x8*)(Vg + (size_t)((k0) + 32 + sr) * ldk + sc); } while (0)
#define SWRITE() do { _Pragma("unroll") for (int cbk = 0; cbk < NKB; ++cbk) { *(ALAS bf16x8*)(lds + L_K + kswz<PITCH>(sr, (cbk * 128 + sc) * 2)) = ks0[cbk]; *(ALAS bf16x8*)(lds + L_K + kswz<PITCH>(32 + sr, (cbk * 128 + sc) * 2)) = ks1[cbk]; } \
        *(ALAS bf16x8*)(lds + L_V + vst0) = vs0; *(ALAS bf16x8*)(lds + L_V + vst1) = vs1; } while (0)
    f32x16 o[4] = {};
    float m_reg = NEG_BIG, l_reg = 0.f, after = 1.f;
    const int NT = MODE == MEM ? 4 : (q0 + UROWS) / 64;
    const float b31 = MODE == DIFF ? io.rel_bias[31 * 8 + h] * LOG2E : 0.f;
    SLOAD(MODE == SB ? (NT - 1) * 64 : 0);
    for (int j = 0; j < NT; ++j) {
        const int kt = MODE == SB ? NT - 1 - j : j, k0 = kt * 64;
        __syncthreads();
        if (MODE == SB && j > 0) { int all = 1;
#pragma unroll
            for (int w = 0; w < 8; ++w) all &= flags[w];
            if (all) break; }
        if (MODE == SB) { const bf16_t* Qpp = Qp; asm volatile("" : "+v"(Qpp));
#pragma unroll
            for (int d0 = 0; d0 < NK; ++d0) qr[d0] = *(const __attribute__((address_space(1))) bf16x8*)(Qpp + d0 * 16 + hi * 8); }
        SWRITE(); if (j + 1 < NT) SLOAD(MODE == SB ? (kt - 1) * 64 : (kt + 1) * 64);
        __syncthreads();
        f32x16 p0, p1;
        if (MODE == MEM) { const bf16_t* Qpp = Qp; asm volatile("" : "+v"(Qpp));
#pragma unroll
            for (int d0 = 0; d0 < NK; ++d0) qr[d0] = *(const __attribute__((address_space(1))) bf16x8*)(Qpp + d0 * 16 + hi * 8); }
        qkt<NK, PITCH>(p0, p1, K_lds, qr, r32, hi, map * 128);
        if (MODE == SB) {
            f32x16 k0v, k1v; float gprod[8], oth[8];
#pragma unroll
            for (int i = 0; i < 8; ++i) { float g = 1.f;
#pragma unroll
                for (int q = 0; q < 4; ++q) { const int r = (i & 3) * 4 + q; const float zl = (i < 4) ? p0[r] : p1[r]; const int key = k0 + q + 8 * (i & 3) + 4 * hi + ((i < 4) ? 0 : 32);
                    const float t = __builtin_amdgcn_exp2f(fminf(zl, 80.f)), kp0 = __builtin_amdgcn_rcpf(1.0f + t);
                    const bool valid = key < qrow; const float kp = valid ? kp0 : 1.0f, sg = valid ? t * kp0 : 0.f;
                    g *= kp; if (i < 4) { k0v[r] = kp; p0[r] = sg; } else { k1v[r] = kp; p1[r] = sg; } }
                gprod[i] = g; }
#pragma unroll
            for (int i = 0; i < 8; ++i) oth[i] = other_half(gprod[i]);
            float Tp = 1.f;
#pragma unroll
            for (int i = 7; i >= 0; --i) { float run = after * Tp * (hi == 0 ? oth[i] : 1.0f);
#pragma unroll
                for (int q = 3; q >= 0; --q) { const int r = (i & 3) * 4 + q;
                    if (i < 4) { p0[r] *= run; run *= k0v[r]; } else { p1[r] *= run; run *= k1v[r]; } }
                Tp *= gprod[i] * oth[i]; }
            after *= Tp;
            if (lane == 0) flags[wid] = 0;
            const int done = __all(after < 1e-37f);
            if (lane == 0) flags[wid] = done;
        } else {
            if (MODE == DIFF) {
                const bool near = (q0 + rg * 32) - (k0 + 63) < 113;
                if (near) {
#pragma unroll
                    for (int r = 0; r < 16; ++r) { const int d0_ = qrow - (k0 + crow(r, hi)), d1_ = d0_ - 32;
                        p0[r] = d0_ < 0 ? NEG_BIG : p0[r] + btab[d0_ < 127 ? d0_ : 127];
                        p1[r] = d1_ < 0 ? NEG_BIG : p1[r] + btab[d1_ < 127 ? d1_ : 127]; }
                } else {
#pragma unroll
                    for (int r = 0; r < 16; ++r) { p0[r] += b31; p1[r] += b31; }
                }
            }
            float pmax = p0[0];
#pragma unroll
            for (int r = 1; r < 16; ++r) pmax = fmaxf(pmax, p0[r]);
#pragma unroll
            for (int r = 0; r < 16; ++r) pmax = fmaxf(pmax, p1[r]);
            pmax = swap_max(pmax);
            const float mn = fmaxf(m_reg, pmax), alpha = __builtin_amdgcn_exp2f(m_reg - mn); m_reg = mn;
            float ps = 0.f;
#pragma unroll
            for (int r = 0; r < 16; ++r) { p0[r] = __builtin_amdgcn_exp2f(p0[r] - mn); p1[r] = __builtin_amdgcn_exp2f(p1[r] - mn); ps += p0[r] + p1[r]; }
            ps = swap_sum(ps);
            l_reg = l_reg * alpha + ps;
            if (__any(alpha < 1.0f)) { if (hi == 0) wsf[r32] = alpha; asm volatile("s_waitcnt lgkmcnt(0)" ::: "memory");
#pragma unroll
                for (int d = 0; d < 4; ++d)
#pragma unroll
                    for (int r = 0; r < 16; ++r) o[d][r] *= wsf[crow(r, hi)]; }
        }
        bf16x8 pa0, pa1, pa2, pa3;
        pack_p(p0, p1, pa0, pa1, pa2, pa3);
        SBAR();
        pv_d0_pipe(o, vb0, pa0, pa1, pa2, pa3);
    }
    float rl[16];
    if (MODE != SB) { if (hi == 0) wsf[32 + r32] = l_reg; asm volatile("s_waitcnt lgkmcnt(0)" ::: "memory");
#pragma unroll
        for (int r = 0; r < 16; ++r) rl[r] = __builtin_amdgcn_rcpf(wsf[32 + crow(r, hi)]); }
    else {
#pragma unroll
        for (int r = 0; r < 16; ++r) rl[r] = 1.0f; }
    if (MODE == DIFF) {
        ALAS float* xch = (ALAS float*)(lds + L_XCH) + rg * 4096;
        if (map == 1) {
#pragma unroll
            for (int d = 0; d < 4; ++d)
#pragma unroll
                for (int r = 0; r < 16; ++r) xch[(d * 16 + r) * 64 + lane] = o[d][r] * rl[r]; }
        __syncthreads();
        if (map == 0) {
            float ss[16];
#pragma unroll
            for (int r = 0; r < 16; ++r) { float s = 0.f;
#pragma unroll
                for (int d = 0; d < 4; ++d) { const float yv = o[d][r] * rl[r] - io.lam * xch[(d * 16 + r) * 64 + lane]; o[d][r] = yv; s += yv * yv; }
                ss[r] = s; }
#pragma unroll
            for (int r = 0; r < 16; ++r) {
#pragma unroll
                for (int off = 1; off < 32; off <<= 1) ss[r] += __shfl_xor(ss[r], off); }
            float sg[4];
#pragma unroll
            for (int d = 0; d < 4; ++d) sg[d] = io.subg[d * 32 + r32] * 0.8f;
#pragma unroll
            for (int r = 0; r < 16; ++r) { const float rs = rsqrtf(ss[r] * (1.0f / 128.0f) + 1e-6f);
                bf16_t* yp = io.y + ((size_t)b * S_ + q0 + rg * 32 + crow(r, hi)) * YW + h * 128 + r32;
#pragma unroll
                for (int d = 0; d < 4; ++d) yp[d * 32] = (bf16_t)(cvtpk(o[d][r] * rs * sg[d], 0.f) & 0xffffu); }
        }
    } else {
        const int ycol = MODE == SB ? 1024 + h * 128 : 2048 + h * 256 + vhalf * 128;
#pragma unroll
        for (int r = 0; r < 16; ++r) { bf16_t* yp = io.y + ((size_t)b * S_ + q0 + rg * 32 + crow(r, hi)) * YW + ycol + r32;
#pragma unroll
            for (int d = 0; d < 4; ++d) yp[d * 32] = (bf16_t)(cvtpk(o[d][r] * rl[r], 0.f) & 0xffffu); }
    }
#undef SLOAD
#undef SWRITE
}

constexpr int D2_SLOT = 32768, D2_WS = 131072 + 2048, D2_BT = D2_WS + 2048;
constexpr float THR2 = 6.0f;
__device__ __forceinline__ void attn_unit_diff2(const AttnIO& io, int b, int h, int qb, ALAS char* lds) {
    const int tid = threadIdx.x, wid = __builtin_amdgcn_readfirstlane(tid >> 6), lane = tid & 63, r32 = lane & 31, hi = lane >> 5;
    const int rg = wid & 3, map = wid >> 2, q0 = qb * 128, qrow = q0 + rg * 32 + r32;
    ALAS float* wsf = (ALAS float*)(lds + D2_WS) + wid * 64;
    ALAS float* dtab = (ALAS float*)(lds + D2_BT);
    const bf16_t* Qp = io.proj + ((size_t)b * S_ + qrow) * INW + C_DQ + h * 128 + map * 64;
    const bf16_t* Kg = io.proj + (size_t)b * S_ * INW + C_DK + h * 128; const bf16_t* Vg = io.proj + (size_t)b * S_ * INW + C_DV + h * 128;
    const float b31 = io.rel_bias[31 * 8 + h] * LOG2E;
    __syncthreads();
    if (tid < 128) dtab[tid] = io.rel_bias[t5_bucket(tid) * 8 + h] * LOG2E - b31;
    unsigned koff[2], voff[2];
#pragma unroll
    for (int i = 0; i < 2; ++i) { const int p = 2 * wid + i, row = 4 * p + (lane >> 4), c = (lane & 15) ^ (row & 7); koff[i] = (unsigned)(row * INW + c * 8);
        const int st = 2 * p + (lane >> 5), kk = (st >> 2) * 8 + ((lane & 31) >> 2), k = (kk & ~0xC) | ((kk & 4) << 1) | ((kk & 8) >> 1), col = (st & 3) * 32 + (lane & 3) * 8; voff[i] = (unsigned)(k * INW + col); }
    const int NT = (q0 + 128) / 64;
#define D2_ISSUE(t) do { const int sl_ = ((t) & 3) * D2_SLOT; const bf16_t* kb_ = Kg + (size_t)(t) * 64 * INW; const bf16_t* vb_ = Vg + (size_t)(t) * 64 * INW; \
        _Pragma("unroll") for (int i_ = 0; i_ < 2; ++i_) { \
            __builtin_amdgcn_global_load_lds((const unsigned*)(kb_ + koff[i_]), (ALAS unsigned*)(lds + sl_ + (2 * wid + i_) * 1024), 16, 0, 0); \
            __builtin_amdgcn_global_load_lds((const unsigned*)(vb_ + voff[i_]), (ALAS unsigned*)(lds + sl_ + 16384 + (2 * wid + i_) * 1024), 16, 0, 0); } } while (0)
    D2_ISSUE(0); D2_ISSUE(1);
    bf16x8 qr[4];
#pragma unroll
    for (int d0 = 0; d0 < 4; ++d0) qr[d0] = *(const bf16x8*)(Qp + d0 * 16 + hi * 8);
    f32x16 o[4] = {}; f32x16 negm;
#pragma unroll
    for (int r = 0; r < 16; ++r) negm[r] = b31;
    float mref = 0.f, l_reg = 0.f;
    const int vbase = (int)(unsigned)(uintptr_t)(lds + 16384) + v_rd_base(lane);
    bf16x8 pa0 = {}, pa1 = {}, pa2 = {}, pa3 = {};
    for (int j = 0; j < NT; ++j) {
        if (j + 1 < NT) asm volatile("s_waitcnt vmcnt(4)" ::: "memory"); else asm volatile("s_waitcnt vmcnt(0)" ::: "memory");
        __builtin_amdgcn_s_barrier(); asm volatile("" ::: "memory");
        if (map == 1 && j > 0) pv_d0_pipe(o, vbase + ((j - 1) & 3) * D2_SLOT, pa0, pa1, pa2, pa3);
        const int k0 = j * 64; const ALAS char* Ks = lds + (j & 3) * D2_SLOT;
        f32x16 p0, p1;
#define D2_SCORES() do { \
        _Pragma("unroll") for (int d0 = 0; d0 < 4; ++d0) { const int cb = map * 128 + (d0 * 16 + hi * 8) * 2; \
            const bf16x8 kb0 = *(const ALAS bf16x8*)(Ks + kswz<256>(r32, cb)), kb1 = *(const ALAS bf16x8*)(Ks + kswz<256>(32 + r32, cb)); \
            if (d0 == 0) { p0 = __builtin_amdgcn_mfma_f32_32x32x16_bf16(kb0, qr[0], negm, 0, 0, 0); p1 = __builtin_amdgcn_mfma_f32_32x32x16_bf16(kb1, qr[0], negm, 0, 0, 0); } \
            else { p0 = __builtin_amdgcn_mfma_f32_32x32x16_bf16(kb0, qr[d0], p0, 0, 0, 0); p1 = __builtin_amdgcn_mfma_f32_32x32x16_bf16(kb1, qr[d0], p1, 0, 0, 0); } } \
        if ((q0 + rg * 32) - (k0 + 63) < 113) { \
            _Pragma("unroll") for (int r = 0; r < 16; ++r) { const int d0_ = qrow - (k0 + crow(r, hi)), d1_ = d0_ - 32; \
                const float t0 = dtab[d0_ < 0 ? 0 : (d0_ < 127 ? d0_ : 127)], t1 = dtab[d1_ < 0 ? 0 : (d1_ < 127 ? d1_ : 127)]; \
                p0[r] = d0_ < 0 ? NEG_BIG : p0[r] + t0; p1[r] = d1_ < 0 ? NEG_BIG : p1[r] + t1; } } } while (0)
#define D2_REBASE() do { \
        float mx0 = fmaxf(fmaxf(p0[0], p0[1]), p0[2]), mx1 = fmaxf(fmaxf(p0[3], p0[4]), p0[5]), mx2 = fmaxf(fmaxf(p1[0], p1[1]), p1[2]), mx3 = fmaxf(fmaxf(p1[3], p1[4]), p1[5]); \
        mx0 = fmaxf(fmaxf(mx0, p0[6]), p0[7]); mx1 = fmaxf(fmaxf(mx1, p0[8]), p0[9]); mx2 = fmaxf(fmaxf(mx2, p1[6]), p1[7]); mx3 = fmaxf(fmaxf(mx3, p1[8]), p1[9]); \
        mx0 = fmaxf(fmaxf(mx0, p0[10]), p0[11]); mx1 = fmaxf(fmaxf(mx1, p0[12]), p0[13]); mx2 = fmaxf(fmaxf(mx2, p1[10]), p1[11]); mx3 = fmaxf(fmaxf(mx3, p1[12]), p1[13]); \
        mx0 = fmaxf(fmaxf(mx0, p0[14]), p0[15]); mx2 = fmaxf(fmaxf(mx2, p1[14]), p1[15]); \
        const float pmax = swap_max(fmaxf(fmaxf(mx0, mx1), fmaxf(mx2, mx3))); \
        const float dl = (j == 0) ? pmax : fmaxf(pmax, 0.f); mref += dl; \
        _Pragma("unroll") for (int r = 0; r < 16; ++r) { p0[r] -= dl; p1[r] -= dl; negm[r] -= dl; } \
        const float alpha = __builtin_amdgcn_exp2f(-dl); l_reg *= alpha; \
        if (j > 0) { if (hi == 0) wsf[r32] = alpha; asm volatile("s_waitcnt lgkmcnt(0)" ::: "memory"); \
            _Pragma("unroll") for (int d = 0; d < 4; ++d) _Pragma("unroll") for (int r = 0; r < 16; ++r) o[d][r] *= wsf[crow(r, hi)]; } } while (0)
#define D2_EXPSUM(PS) do { \
        _Pragma("unroll") for (int r = 0; r < 16; ++r) { p0[r] = __builtin_amdgcn_exp2f(p0[r]); p1[r] = __builtin_amdgcn_exp2f(p1[r]); } \
        float ps0 = p0[0] + p1[0], ps1 = p0[1] + p1[1], ps2 = p0[2] + p1[2], ps3 = p0[3] + p1[3]; \
        _Pragma("unroll") for (int r = 4; r < 16; r += 4) { ps0 += p0[r] + p1[r]; ps1 += p0[r + 1] + p1[r + 1]; ps2 += p0[r + 2] + p1[r + 2]; ps3 += p0[r + 3] + p1[r + 3]; } \
        PS = swap_sum((ps0 + ps1) + (ps2 + ps3)); } while (0)
        D2_SCORES();
        if (j == 0) D2_REBASE();
        float ps_row;
        D2_EXPSUM(ps_row);
        if (j > 0 && __any(!(ps_row < 8192.0f))) { D2_SCORES(); D2_REBASE(); D2_EXPSUM(ps_row); }
        l_reg += ps_row;
#undef D2_SCORES
#undef D2_REBASE
#undef D2_EXPSUM
        asm volatile("" ::: "memory");
        if (j + 2 < NT) D2_ISSUE(j + 2);
        asm volatile("" ::: "memory");
        pack_p(p0, p1, pa0, pa1, pa2, pa3);
        SBAR();
        if (map == 0) pv_d0_pipe(o, vbase + (j & 3) * D2_SLOT, pa0, pa1, pa2, pa3);
    }
    if (map == 1) pv_d0_pipe(o, vbase + ((NT - 1) & 3) * D2_SLOT, pa0, pa1, pa2, pa3);
#undef D2_ISSUE
    if (hi == 0) wsf[32 + r32] = l_reg; asm volatile("s_waitcnt lgkmcnt(0)" ::: "memory");
    float rl[16];
#pragma unroll
    for (int r = 0; r < 16; ++r) rl[r] = __builtin_amdgcn_rcpf(wsf[32 + crow(r, hi)]);
    __syncthreads();
    ALAS float* xch = (ALAS float*)lds + rg * 4096;
    if (map == 1) {
#pragma unroll
        for (int d = 0; d < 4; ++d)
#pragma unroll
            for (int r = 0; r < 16; ++r) xch[(d * 16 + r) * 64 + lane] = o[d][r] * rl[r]; }
    __syncthreads();
    if (map == 0) {
        float ss[16];
#pragma unroll
        for (int r = 0; r < 16; ++r) { float s = 0.f;
#pragma unroll
            for (int d = 0; d < 4; ++d) { const float yv = o[d][r] * rl[r] - io.lam * xch[(d * 16 + r) * 64 + lane]; o[d][r] = yv; s += yv * yv; }
            ss[r] = s; }
#pragma unroll
        for (int r = 0; r < 16; ++r) {
#pragma unroll
            for (int off = 1; off < 32; off <<= 1) ss[r] += __shfl_xor(ss[r], off); }
        float sg[4];
#pragma unroll
        for (int d = 0; d < 4; ++d) sg[d] = io.subg[d * 32 + r32] * 0.8f;
#pragma unroll
        for (int r = 0; r < 16; ++r) { const float rs = rsqrtf(ss[r] * (1.0f / 128.0f) + 1e-6f);
            bf16_t* yp = io.y + ((size_t)b * S_ + q0 + rg * 32 + crow(r, hi)) * YW + h * 128 + r32;
#pragma unroll
            for (int d = 0; d < 4; ++d) yp[d * 32] = (bf16_t)(cvtpk(o[d][r] * rs * sg[d], 0.f) & 0xffffu); }
    }
}

struct CvCtx { const float* w1; const float* w2; unsigned char* d1; unsigned char* d2; float sc; };
constexpr int CV_TOTAL = 32 * 64 * 128 + 32 * 64 * 64;
constexpr int D3_STG = 98304;
__device__ __forceinline__ int cv_unit_items(int qb) { return 8 * (2 * (qb + 1) - ((qb + 1) >> 1)); }
__device__ __forceinline__ int cv_unit_base(int bh, int qb) { return bh * (8 * 3136) + 8 * (qb * (qb + 1) - ((qb * qb) >> 2)); }
__device__ __forceinline__ void cv_decode(const CvCtx& cv, int g, const float*& src, int& N, unsigned char*& dst) {
    if (g < 32 * 64 * 128) { const int e = g >> 13, r = g & 8191, nb = r >> 6, kb = r & 63, n0 = nb * 32, k0 = kb * 32;
        const int nn = n0 & 2047, drow = (nn >> 7) * 256 + (n0 >= 2048 ? 128 : 0) + (nn & 127);
        src = cv.w1 + (size_t)e * 2048 * 4096 + (size_t)k0 * 4096 + n0; N = 4096; dst = cv.d1 + ((size_t)e * 4096 + drow) * LD_F8 + k0; }
    else { const int g2 = g - 32 * 64 * 128, e = g2 >> 12, r = g2 & 4095, nb = r >> 6, kb = r & 63, n0 = nb * 32, k0 = kb * 32;
        src = cv.w2 + (size_t)e * 2048 * 2048 + (size_t)k0 * 2048 + n0; N = 2048; dst = cv.d2 + ((size_t)e * 2048 + n0) * LD_F8 + k0; }
}
__device__ __forceinline__ void cv_issue(const float* src, int N, ALAS char* stg, int lane) {
#pragma unroll
    for (int q = 0; q < 4; ++q) { const int kr = 8 * q + (lane >> 3), c4 = (lane & 7) ^ (kr & 7);
        __builtin_amdgcn_global_load_lds((const unsigned*)(src + (size_t)kr * N + 4 * c4), (ALAS unsigned*)(stg + q * 1024), 16, 0, 2); }
}
__device__ __forceinline__ unsigned pk4_fp8_att(float a, float b, float c, float d) {
    a = __builtin_amdgcn_fmed3f(a, -448.f, 448.f); b = __builtin_amdgcn_fmed3f(b, -448.f, 448.f); c = __builtin_amdgcn_fmed3f(c, -448.f, 448.f); d = __builtin_amdgcn_fmed3f(d, -448.f, 448.f);
    int w = 0; w = __builtin_amdgcn_cvt_pk_fp8_f32(a, b, w, false); w = __builtin_amdgcn_cvt_pk_fp8_f32(c, d, w, true); return (unsigned)w;
}
#define VM_WAIT_LE(n) do { if ((n) >= 8) asm volatile("s_waitcnt vmcnt(8)" ::: "memory"); else if ((n) >= 4) asm volatile("s_waitcnt vmcnt(4)" ::: "memory"); else asm volatile("s_waitcnt vmcnt(0)" ::: "memory"); } while (0)
__device__ __forceinline__ void attn_unit_diff3(const AttnIO& io, const CvCtx& cv, int b, int h, int qb, ALAS char* lds) {
    const int tid = threadIdx.x, wid = __builtin_amdgcn_readfirstlane(tid >> 6), lane = tid & 63, r32 = lane & 31, hi = lane >> 5;
    const int rg = wid & 3, map = wid >> 2, q0 = qb * 128, qrow = q0 + rg * 32 + r32;
    ALAS float* wsf = (ALAS float*)(lds + D2_WS) + wid * 64;
    ALAS float* dtab = (ALAS float*)(lds + D2_BT);
    ALAS char* stg = lds + D3_STG + wid * 4096;
    const bf16_t* Qp = io.proj + ((size_t)b * S_ + qrow) * INW + C_DQ + h * 128 + map * 64;
    const bf16_t* Kg = io.proj + (size_t)b * S_ * INW + C_DK + h * 128; const bf16_t* Vg = io.proj + (size_t)b * S_ * INW + C_DV + h * 128;
    const float b31 = io.rel_bias[31 * 8 + h] * LOG2E;
    const int NT = (q0 + 128) / 64;
    const int per = cv_unit_items(qb) >> 3; int it0 = cv_unit_base(b * 8 + h, qb) + wid * per; int nit = CV_TOTAL - it0; nit = nit < 0 ? 0 : (nit > per ? per : nit);
    __syncthreads();
    if (tid < 128) dtab[tid] = io.rel_bias[t5_bucket(tid) * 8 + h] * LOG2E - b31;
    unsigned koff[2], voff[2];
#pragma unroll
    for (int i = 0; i < 2; ++i) { const int p = 2 * wid + i, row = 4 * p + (lane >> 4), c = (lane & 15) ^ (row & 7); koff[i] = (unsigned)(row * INW + c * 8);
        const int st = 2 * p + (lane >> 5), kk = (st >> 2) * 8 + ((lane & 31) >> 2), k = (kk & ~0xC) | ((kk & 4) << 1) | ((kk & 8) >> 1), col = (st & 3) * 32 + (lane & 3) * 8; voff[i] = (unsigned)(k * INW + col); }
    int sl_j = 0, sl_n = 2 * D2_SLOT;
#define D3_ISSUE(t, sl_) do { const bf16_t* kb_ = Kg + (size_t)(t) * 64 * INW; const bf16_t* vb_ = Vg + (size_t)(t) * 64 * INW; \
        _Pragma("unroll") for (int i_ = 0; i_ < 2; ++i_) { \
            __builtin_amdgcn_global_load_lds((const unsigned*)(kb_ + koff[i_]), (ALAS unsigned*)(lds + (sl_) + (2 * wid + i_) * 1024), 16, 0, 0); \
            __builtin_amdgcn_global_load_lds((const unsigned*)(vb_ + voff[i_]), (ALAS unsigned*)(lds + (sl_) + 16384 + (2 * wid + i_) * 1024), 16, 0, 0); } } while (0)
    int sk0, sk1, sd = 0, cr = 0;
    D3_ISSUE(0, 0); D3_ISSUE(1, D2_SLOT); sk0 = 4; sk1 = 0;
    if (nit > 0) { const float* src; int N; unsigned char* dst; cv_decode(cv, it0, src, N, dst); cv_issue(src, N, stg, lane); sk0 += 4; sk1 += 4; sd = 0; }
    asm volatile("" ::: "memory");
    bf16x8 qr[4];
#pragma unroll
    for (int d0 = 0; d0 < 4; ++d0) qr[d0] = *(const bf16x8*)(Qp + d0 * 16 + hi * 8);
    f32x16 o[4] = {}; f32x16 negm;
#pragma unroll
    for (int r = 0; r < 16; ++r) negm[r] = b31;
    float mref = 0.f, l_reg = 0.f;
    const int vbase = (int)(unsigned)(uintptr_t)(lds + 16384) + v_rd_base(lane);
    for (int j = 0; j < NT; ++j) {
        const bool cvt = ((j & 3) != 3) && cr < nit;
        { const int allow = cvt ? (sk0 < sd ? sk0 : sd) : sk0; VM_WAIT_LE(allow); }
        __builtin_amdgcn_s_barrier(); asm volatile("" ::: "memory");
        if (cvt) {
            const float* src; int N; unsigned char* dst; cv_decode(cv, it0 + cr, src, N, dst);
            const int n = lane & 31, kh = lane >> 5; const ALAS float* sp = (const ALAS float*)stg;
            float v[16];
#pragma unroll
            for (int i = 0; i < 16; ++i) { const int k = 16 * kh + i; v[i] = sp[k * 32 + ((((n >> 2) ^ (k & 7)) << 2) | (n & 3))]; }
            asm volatile("s_waitcnt lgkmcnt(0)" ::: "memory");
            if (cr + 1 < nit) { const float* s2; int N2; unsigned char* d2; cv_decode(cv, it0 + cr + 1, s2, N2, d2); cv_issue(s2, N2, stg, lane); sk0 += 4; sk1 += 4; sd = 0; }
            asm volatile("" ::: "memory");
            u32x4 w; const float sc = cv.sc;
            w.x = pk4_fp8_att(v[0] * sc, v[1] * sc, v[2] * sc, v[3] * sc); w.y = pk4_fp8_att(v[4] * sc, v[5] * sc, v[6] * sc, v[7] * sc);
            w.z = pk4_fp8_att(v[8] * sc, v[9] * sc, v[10] * sc, v[11] * sc); w.w = pk4_fp8_att(v[12] * sc, v[13] * sc, v[14] * sc, v[15] * sc);
            *(__attribute__((address_space(1))) u32x4*)(dst + (size_t)n * LD_F8 + 16 * kh) = w;
            asm volatile("" ::: "memory");
            ++cr;
        }
        if (j + 2 < NT) { D3_ISSUE(j + 2, sl_n); sd += 4; sk0 = sk1 + 4; sk1 = 0; } else { sk0 = sk1; sk1 = 0; }
        asm volatile("" ::: "memory");
        const int k0 = j * 64; const ALAS char* Ks = lds + sl_j;
        f32x16 p0, p1;
#pragma unroll
        for (int d0 = 0; d0 < 4; ++d0) { const int cb = map * 128 + (d0 * 16 + hi * 8) * 2;
            const bf16x8 kb0 = *(const ALAS bf16x8*)(Ks + kswz<256>(r32, cb)), kb1 = *(const ALAS bf16x8*)(Ks + kswz<256>(32 + r32, cb));
            if (d0 == 0) { p0 = __builtin_amdgcn_mfma_f32_32x32x16_bf16(kb0, qr[0], negm, 0, 0, 0); p1 = __builtin_amdgcn_mfma_f32_32x32x16_bf16(kb1, qr[0], negm, 0, 0, 0); }
            else { p0 = __builtin_amdgcn_mfma_f32_32x32x16_bf16(kb0, qr[d0], p0, 0, 0, 0); p1 = __builtin_amdgcn_mfma_f32_32x32x16_bf16(kb1, qr[d0], p1, 0, 0, 0); } }
        if ((q0 + rg * 32) - (k0 + 63) < 113) {
#pragma unroll
            for (int r = 0; r < 16; ++r) { const int d0_ = qrow - (k0 + crow(r, hi)), d1_ = d0_ - 32;
                const float t0 = dtab[d0_ < 0 ? 0 : (d0_ < 127 ? d0_ : 127)], t1 = dtab[d1_ < 0 ? 0 : (d1_ < 127 ? d1_ : 127)];
                p0[r] = d0_ < 0 ? NEG_BIG : p0[r] + t0; p1[r] = d1_ < 0 ? NEG_BIG : p1[r] + t1; } }
        float mx0 = fmaxf(fmaxf(p0[0], p0[1]), p0[2]), mx1 = fmaxf(fmaxf(p0[3], p0[4]), p0[5]), mx2 = fmaxf(fmaxf(p1[0], p1[1]), p1[2]), mx3 = fmaxf(fmaxf(p1[3], p1[4]), p1[5]);
        mx0 = fmaxf(fmaxf(mx0, p0[6]), p0[7]); mx1 = fmaxf(fmaxf(mx1, p0[8]), p0[9]); mx2 = fmaxf(fmaxf(mx2, p1[6]), p1[7]); mx3 = fmaxf(fmaxf(mx3, p1[8]), p1[9]);
        mx0 = fmaxf(fmaxf(mx0, p0[10]), p0[11]); mx1 = fmaxf(fmaxf(mx1, p0[12]), p0[13]); mx2 = fmaxf(fmaxf(mx2, p1[10]), p1[11]); mx3 = fmaxf(fmaxf(mx3, p1[12]), p1[13]);
        mx0 = fmaxf(fmaxf(mx0, p0[14]), p0[15]); mx2 = fmaxf(fmaxf(mx2, p1[14]), p1[15]);
        float pmax = swap_max(fmaxf(fmaxf(mx0, mx1), fmaxf(mx2, mx3)));
        if (j == 0 || __any(pmax > THR2)) {
            const float dl = (j == 0) ? pmax : fmaxf(pmax, 0.f); mref += dl;
#pragma unroll
            for (int r = 0; r < 16; ++r) { p0[r] -= dl; p1[r] -= dl; negm[r] -= dl; }
            const float alpha = __builtin_amdgcn_exp2f(-dl); l_reg *= alpha;
            if (j > 0) { if (hi == 0) wsf[r32] = alpha; asm volatile("s_waitcnt lgkmcnt(0)" ::: "memory");
#pragma unroll
                for (int d = 0; d < 4; ++d)
#pragma unroll
                    for (int r = 0; r < 16; ++r) o[d][r] *= wsf[crow(r, hi)]; } }
#pragma unroll
        for (int r = 0; r < 16; ++r) { p0[r] = __builtin_amdgcn_exp2f(p0[r]); p1[r] = __builtin_amdgcn_exp2f(p1[r]); }
        float ps0 = p0[0] + p1[0], ps1 = p0[1] + p1[1], ps2 = p0[2] + p1[2], ps3 = p0[3] + p1[3];
#pragma unroll
        for (int r = 4; r < 16; r += 4) { ps0 += p0[r] + p1[r]; ps1 += p0[r + 1] + p1[r + 1]; ps2 += p0[r + 2] + p1[r + 2]; ps3 += p0[r + 3] + p1[r + 3]; }
        l_reg += swap_sum((ps0 + ps1) + (ps2 + ps3));
        bf16x8 pa0, pa1, pa2, pa3;
        pack_p(p0, p1, pa0, pa1, pa2, pa3);
        SBAR();
        pv_d0_pipe(o, vbase + sl_j, pa0, pa1, pa2, pa3);
        sl_j = (sl_j == 2 * D2_SLOT) ? 0 : sl_j + D2_SLOT; sl_n = (sl_n == 2 * D2_SLOT) ? 0 : sl_n + D2_SLOT;
    }
#undef D3_ISSUE
    while (cr < nit) {
        asm volatile("s_waitcnt vmcnt(0)" ::: "memory");
        const float* src; int N; unsigned char* dst; cv_decode(cv, it0 + cr, src, N, dst);
        const int n = lane & 31, kh = lane >> 5; const ALAS float* sp = (const ALAS float*)stg;
        float v[16];
#pragma unroll
        for (int i = 0; i < 16; ++i) { const int k = 16 * kh + i; v[i] = sp[k * 32 + ((((n >> 2) ^ (k & 7)) << 2) | (n & 3))]; }
        asm volatile("s_waitcnt lgkmcnt(0)" ::: "memory");
        if (cr + 1 < nit) { const float* s2; int N2; unsigned char* d2; cv_decode(cv, it0 + cr + 1, s2, N2, d2); cv_issue(s2, N2, stg, lane); }
        asm volatile("" ::: "memory");
        u32x4 w; const float sc = cv.sc;
        w.x = pk4_fp8_att(v[0] * sc, v[1] * sc, v[2] * sc, v[3] * sc); w.y = pk4_fp8_att(v[4] * sc, v[5] * sc, v[6] * sc, v[7] * sc);
        w.z = pk4_fp8_att(v[8] * sc, v[9] * sc, v[10] * sc, v[11] * sc); w.w = pk4_fp8_att(v[12] * sc, v[13] * sc, v[14] * sc, v[15] * sc);
        *(__attribute__((address_space(1))) u32x4*)(dst + (size_t)n * LD_F8 + 16 * kh) = w;
        ++cr;
    }
    if (hi == 0) wsf[32 + r32] = l_reg; asm volatile("s_waitcnt lgkmcnt(0)" ::: "memory");
    float rl[16];
#pragma unroll
    for (int r = 0; r < 16; ++r) rl[r] = __builtin_amdgcn_rcpf(wsf[32 + crow(r, hi)]);
    asm volatile("s_waitcnt vmcnt(0)" ::: "memory");
    __syncthreads();
    ALAS float* xch = (ALAS float*)lds + rg * 4096;
    if (map == 1) {
#pragma unroll
        for (int d = 0; d < 4; ++d)
#pragma unroll
            for (int r = 0; r < 16; ++r) xch[(d * 16 + r) * 64 + lane] = o[d][r] * rl[r]; }
    __syncthreads();
    if (map == 0) {
        float ss[16];
#pragma unroll
        for (int r = 0; r < 16; ++r) { float s = 0.f;
#pragma unroll
            for (int d = 0; d < 4; ++d) { const float yv = o[d][r] * rl[r] - io.lam * xch[(d * 16 + r) * 64 + lane]; o[d][r] = yv; s += yv * yv; }
            ss[r] = s; }
#pragma unroll
        for (int r = 0; r < 16; ++r) {
#pragma unroll
            for (int off = 1; off < 32; off <<= 1) ss[r] += __shfl_xor(ss[r], off); }
        float sg[4];
#pragma unroll
        for (int d = 0; d < 4; ++d) sg[d] = io.subg[d * 32 + r32] * 0.8f;
#pragma unroll
        for (int r = 0; r < 16; ++r) { const float rs = rsqrtf(ss[r] * (1.0f / 128.0f) + 1e-6f);
            bf16_t* yp = io.y + ((size_t)b * S_ + q0 + rg * 32 + crow(r, hi)) * YW + h * 128 + r32;
#pragma unroll
            for (int d = 0; d < 4; ++d) yp[d * 32] = (bf16_t)(cvtpk(o[d][r] * rs * sg[d], 0.f) & 0xffffu); }
    }
}
#undef VM_WAIT_LE
constexpr int CV4_TOTAL = 32 * 128 * 128;
__device__ __forceinline__ int cv4_unit_base(int bh, int qb) { return bh * (8 * 4160) + 8 * qb * (qb + 1); }
__device__ __forceinline__ void cv4_decode(const CvCtx& cv, int g, const float*& src, unsigned char*& dst) {
    const int e = g >> 14, r = g & 16383, nb = r >> 7, kb = r & 127, n0 = nb * 32, k0 = kb * 16;
    const int nn = n0 & 2047, drow = (nn >> 7) * 256 + (n0 >= 2048 ? 128 : 0) + (nn & 127);
    src = cv.w1 + (size_t)e * 2048 * 4096 + (size_t)k0 * 4096 + n0; dst = cv.d1 + ((size_t)e * 4096 + drow) * LD_F8 + k0;
}
__device__ __forceinline__ void cv4_issue(const float* src, ALAS char* stg, int lane) {
#pragma unroll
    for (int q = 0; q < 2; ++q) { const int kr = 8 * q + (lane >> 3), c4 = (lane & 7) ^ (kr & 7);
        __builtin_amdgcn_global_load_lds((const unsigned*)(src + (size_t)kr * 4096 + 4 * c4), (ALAS unsigned*)(stg + q * 1024), 16, 0, 2); }
}
#define VM_WAIT_LE(n) do { if ((n) >= 10) asm volatile("s_waitcnt vmcnt(10)" ::: "memory"); else if ((n) >= 8) asm volatile("s_waitcnt vmcnt(8)" ::: "memory"); else if ((n) >= 6) asm volatile("s_waitcnt vmcnt(6)" ::: "memory"); \
    else if ((n) >= 4) asm volatile("s_waitcnt vmcnt(4)" ::: "memory"); else if ((n) >= 2) asm volatile("s_waitcnt vmcnt(2)" ::: "memory"); else asm volatile("s_waitcnt vmcnt(0)" ::: "memory"); } while (0)
__device__ __forceinline__ void attn_unit_diff4(const AttnIO& io, const CvCtx& cv, int b, int h, int qb, ALAS char* lds) {
    const int tid = threadIdx.x, wid = __builtin_amdgcn_readfirstlane(tid >> 6), lane = tid & 63, r32 = lane & 31, hi = lane >> 5;
    const int rg = wid & 3, map = wid >> 2, q0 = qb * 128, qrow = q0 + rg * 32 + r32;
    ALAS float* wsf = (ALAS float*)(lds + D2_WS) + wid * 64;
    ALAS float* dtab = (ALAS float*)(lds + D2_BT);
    ALAS char* stg = lds + 98304 + wid * 4096;
    const bf16_t* Qp = io.proj + ((size_t)b * S_ + qrow) * INW + C_DQ + h * 128 + map * 64;
    const bf16_t* Kg = io.proj + (size_t)b * S_ * INW + C_DK + h * 128; const bf16_t* Vg = io.proj + (size_t)b * S_ * INW + C_DV + h * 128;
    const float b31 = io.rel_bias[31 * 8 + h] * LOG2E;
    const int NT = (q0 + 128) / 64;
    const int per = NT; int it0 = cv4_unit_base(b * 8 + h, qb) + wid * per; int nit = CV4_TOTAL - it0; nit = nit < 0 ? 0 : (nit > per ? per : nit);
    __syncthreads();
    if (tid < 128) dtab[tid] = io.rel_bias[t5_bucket(tid) * 8 + h] * LOG2E - b31;
    unsigned koff[2], voff[2];
#pragma unroll
    for (int i = 0; i < 2; ++i) { const int p = 2 * wid + i, row = 4 * p + (lane >> 4), c = (lane & 15) ^ (row & 7); koff[i] = (unsigned)(row * INW + c * 8);
        const int st = 2 * p + (lane >> 5), kk = (st >> 2) * 8 + ((lane & 31) >> 2), k = (kk & ~0xC) | ((kk & 4) << 1) | ((kk & 8) >> 1), col = (st & 3) * 32 + (lane & 3) * 8; voff[i] = (unsigned)(k * INW + col); }
    int sl_j = 0, sl_n = 2 * D2_SLOT;
#define D3_ISSUE(t, sl_) do { const bf16_t* kb_ = Kg + (size_t)(t) * 64 * INW; const bf16_t* vb_ = Vg + (size_t)(t) * 64 * INW; \
        _Pragma("unroll") for (int i_ = 0; i_ < 2; ++i_) { \
            __builtin_amdgcn_global_load_lds((const unsigned*)(kb_ + koff[i_]), (ALAS unsigned*)(lds + (sl_) + (2 * wid + i_) * 1024), 16, 0, 0); \
            __builtin_amdgcn_global_load_lds((const unsigned*)(vb_ + voff[i_]), (ALAS unsigned*)(lds + (sl_) + 16384 + (2 * wid + i_) * 1024), 16, 0, 0); } } while (0)
    int sk0, sk1, sdA = 0, sdB = 0, cr = 0;
    D3_ISSUE(0, 0); D3_ISSUE(1, D2_SLOT); sk0 = 4; sk1 = 0;
    if (nit > 0) { const float* src; unsigned char* dst; cv4_decode(cv, it0, src, dst); cv4_issue(src, stg, lane); sk0 += 2; sk1 += 2; sdA = 0; }
    if (nit > 1) { const float* src; unsigned char* dst; cv4_decode(cv, it0 + 1, src, dst); cv4_issue(src, stg + 2048, lane); sk0 += 2; sk1 += 2; sdA += 2; sdB = 0; }
    asm volatile("" ::: "memory");
    bf16x8 qr[4];
#pragma unroll
    for (int d0 = 0; d0 < 4; ++d0) qr[d0] = *(const bf16x8*)(Qp + d0 * 16 + hi * 8);
    f32x16 o[4] = {}; f32x16 negm;
#pragma unroll
    for (int r = 0; r < 16; ++r) negm[r] = b31;
    float mref = 0.f, l_reg = 0.f;
    const int vbase = (int)(unsigned)(uintptr_t)(lds + 16384) + v_rd_base(lane);
    for (int j = 0; j < NT; ++j) {
        const bool cvt = cr < nit;
        { const int sdx = (cr & 1) ? sdB : sdA; const int allow = cvt ? (sk0 < sdx ? sk0 : sdx) : sk0; VM_WAIT_LE(allow); }
        __builtin_amdgcn_s_barrier(); asm volatile("" ::: "memory");
        if (cvt) {
            const float* src; unsigned char* dst; cv4_decode(cv, it0 + cr, src, dst);
            const int n = lane & 31, kh = lane >> 5; const ALAS float* sp = (const ALAS float*)(stg + (cr & 1) * 2048);
            float v[8];
#pragma unroll
            for (int i = 0; i < 8; ++i) { const int k = 8 * kh + i; v[i] = sp[k * 32 + ((((n >> 2) ^ (k & 7)) << 2) | (n & 3))]; }
            asm volatile("s_waitcnt lgkmcnt(0)" ::: "memory");
            if (cr + 2 < nit) { const float* s2; unsigned char* d2; cv4_decode(cv, it0 + cr + 2, s2, d2); cv4_issue(s2, stg + (cr & 1) * 2048, lane); sk0 += 2; sk1 += 2; sdA += 2; sdB += 2; if (cr & 1) sdB = 0; else sdA = 0; }
            asm volatile("" ::: "memory");
            const float sc = cv.sc; typedef int i32x2_t __attribute__((ext_vector_type(2)));
            const i32x2_t w = {(int)pk4_fp8_att(v[0] * sc, v[1] * sc, v[2] * sc, v[3] * sc), (int)pk4_fp8_att(v[4] * sc, v[5] * sc, v[6] * sc, v[7] * sc)};
            *(__attribute__((address_space(1))) i32x2_t*)(dst + (size_t)n * LD_F8 + 8 * kh) = w;
            asm volatile("" ::: "memory");
            ++cr;
        }
        if (j + 2 < NT) { D3_ISSUE(j + 2, sl_n); sdA += 4; sdB += 4; sk0 = sk1 + 4; sk1 = 0; } else { sk0 = sk1; sk1 = 0; }
        asm volatile("" ::: "memory");
        const int k0 = j * 64; const ALAS char* Ks = lds + sl_j;
        f32x16 p0, p1;
#pragma unroll
        for (int d0 = 0; d0 < 4; ++d0) { const int cb = map * 128 + (d0 * 16 + hi * 8) * 2;
            const bf16x8 kb0 = *(const ALAS bf16x8*)(Ks + kswz<256>(r32, cb)), kb1 = *(const ALAS bf16x8*)(Ks + kswz<256>(32 + r32, cb));
            if (d0 == 0) { p0 = __builtin_amdgcn_mfma_f32_32x32x16_bf16(kb0, qr[0], negm, 0, 0, 0); p1 = __builtin_amdgcn_mfma_f32_32x32x16_bf16(kb1, qr[0], negm, 0, 0, 0); }
            else { p0 = __builtin_amdgcn_mfma_f32_32x32x16_bf16(kb0, qr[d0], p0, 0, 0, 0); p1 = __builtin_amdgcn_mfma_f32_32x32x16_bf16(kb1, qr[d0], p1, 0, 0, 0); } }
        if ((q0 + rg * 32) - (k0 + 63) < 113) {
#pragma unroll
            for (int r = 0; r < 16; ++r) { const int d0_ = qrow - (k0 + crow(r, hi)), d1_ = d0_ - 32;
                const float t0 = dtab[d0_ < 0 ? 0 : (d0_ < 127 ? d0_ : 127)], t1 = dtab[d1_ < 0 ? 0 : (d1_ < 127 ? d1_ : 127)];
                p0[r] = d0_ < 0 ? NEG_BIG : p0[r] + t0; p1[r] = d1_ < 0 ? NEG_BIG : p1[r] + t1; } }
        float mx0 = fmaxf(fmaxf(p0[0], p0[1]), p0[2]), mx1 = fmaxf(fmaxf(p0[3], p0[4]), p0[5]), mx2 = fmaxf(fmaxf(p1[0], p1[1]), p1[2]), mx3 = fmaxf(fmaxf(p1[3], p1[4]), p1[5]);
        mx0 = fmaxf(fmaxf(mx0, p0[6]), p0[7]); mx1 = fmaxf(fmaxf(mx1, p0[8]), p0[9]); mx2 = fmaxf(fmaxf(mx2, p1[6]), p1[7]); mx3 = fmaxf(fmaxf(mx3, p1[8]), p1[9]);
        mx0 = fmaxf(fmaxf(mx0, p0[10]), p0[11]); mx1 = fmaxf(fmaxf(mx1, p0[12]), p0[13]); mx2 = fmaxf(fmaxf(mx2, p1[10]), p1[11]); mx3 = fmaxf(fmaxf(mx3, p1[12]), p1[13]);
        mx0 = fmaxf(fmaxf(mx0, p0[14]), p0[15]); mx2 = fmaxf(fmaxf(mx2, p1[14]), p1[15]);
        float pmax = swap_max(fmaxf(fmaxf(mx0, mx1), fmaxf(mx2, mx3)));
        if (j == 0 || __any(pmax > THR2)) {
            const float dl = (j == 0) ? pmax : fmaxf(pmax, 0.f); mref += dl;
#pragma unroll
            for (int r = 0; r < 16; ++r) { p0[r] -= dl; p1[r] -= dl; negm[r] -= dl; }
            const float alpha = __builtin_amdgcn_exp2f(-dl); l_reg *= alpha;
            if (j > 0) { if (hi == 0) wsf[r32] = alpha; asm volatile("s_waitcnt lgkmcnt(0)" ::: "memory");
#pragma unroll
                for (int d = 0; d < 4; ++d)
#pragma unroll
                    for (int r = 0; r < 16; ++r) o[d][r] *= wsf[crow(r, hi)]; } }
#pragma unroll
        for (int r = 0; r < 16; ++r) { p0[r] = __builtin_amdgcn_exp2f(p0[r]); p1[r] = __builtin_amdgcn_exp2f(p1[r]); }
        float ps0 = p0[0] + p1[0], ps1 = p0[1] + p1[1], ps2 = p0[2] + p1[2], ps3 = p0[3] + p1[3];
#pragma unroll
        for (int r = 4; r < 16; r += 4) { ps0 += p0[r] + p1[r]; ps1 += p0[r + 1] + p1[r + 1]; ps2 += p0[r + 2] + p1[r + 2]; ps3 += p0[r + 3] + p1[r + 3]; }
        l_reg += swap_sum((ps0 + ps1) + (ps2 + ps3));
        bf16x8 pa0, pa1, pa2, pa3;
        pack_p(p0, p1, pa0, pa1, pa2, pa3);
        SBAR();
        pv_d0_pipe(o, vbase + sl_j, pa0, pa1, pa2, pa3);
        sl_j = (sl_j == 2 * D2_SLOT) ? 0 : sl_j + D2_SLOT; sl_n = (sl_n == 2 * D2_SLOT) ? 0 : sl_n + D2_SLOT;
    }
#undef D3_ISSUE
    while (cr < nit) {
        asm volatile("s_waitcnt vmcnt(0)" ::: "memory");
        const float* src; unsigned char* dst; cv4_decode(cv, it0 + cr, src, dst);
        const int n = lane & 31, kh = lane >> 5; const ALAS float* sp = (const ALAS float*)(stg + (cr & 1) * 2048);
        float v[8];
#pragma unroll
        for (int i = 0; i < 8; ++i) { const int k = 8 * kh + i; v[i] = sp[k * 32 + ((((n >> 2) ^ (k & 7)) << 2) | (n & 3))]; }
        asm volatile("s_waitcnt lgkmcnt(0)" ::: "memory");
        if (cr + 2 < nit) { const float* s2; unsigned char* d2; cv4_decode(cv, it0 + cr + 2, s2, d2); cv4_issue(s2, stg + (cr & 1) * 2048, lane); }
        asm volatile("" ::: "memory");
        const float sc = cv.sc; typedef int i32x2_t __attribute__((ext_vector_type(2)));
        const i32x2_t w = {(int)pk4_fp8_att(v[0] * sc, v[1] * sc, v[2] * sc, v[3] * sc), (int)pk4_fp8_att(v[4] * sc, v[5] * sc, v[6] * sc, v[7] * sc)};
        *(__attribute__((address_space(1))) i32x2_t*)(dst + (size_t)n * LD_F8 + 8 * kh) = w;
        ++cr;
    }
    if (hi == 0) wsf[32 + r32] = l_reg; asm volatile("s_waitcnt lgkmcnt(0)" ::: "memory");
    float rl[16];
#pragma unroll
    for (int r = 0; r < 16; ++r) rl[r] = __builtin_amdgcn_rcpf(wsf[32 + crow(r, hi)]);
    asm volatile("s_waitcnt vmcnt(0)" ::: "memory");
    __syncthreads();
    ALAS float* xch = (ALAS float*)lds + rg * 4096;
    if (map == 1) {
#pragma unroll
        for (int d = 0; d < 4; ++d)
#pragma unroll
            for (int r = 0; r < 16; ++r) xch[(d * 16 + r) * 64 + lane] = o[d][r] * rl[r]; }
    __syncthreads();
    if (map == 0) {
        float ss[16];
#pragma unroll
        for (int r = 0; r < 16; ++r) { float s = 0.f;
#pragma unroll
            for (int d = 0; d < 4; ++d) { const float yv = o[d][r] * rl[r] - io.lam * xch[(d * 16 + r) * 64 + lane]; o[d][r] = yv; s += yv * yv; }
            ss[r] = s; }
#pragma unroll
        for (int r = 0; r < 16; ++r) {
#pragma unroll
            for (int off = 1; off < 32; off <<= 1) ss[r] += __shfl_xor(ss[r], off); }
        float sg[4];
#pragma unroll
        for (int d = 0; d < 4; ++d) sg[d] = io.subg[d * 32 + r32] * 0.8f;
#pragma unroll
        for (int r = 0; r < 16; ++r) { const float rs = rsqrtf(ss[r] * (1.0f / 128.0f) + 1e-6f);
            bf16_t* yp = io.y + ((size_t)b * S_ + q0 + rg * 32 + crow(r, hi)) * YW + h * 128 + r32;
#pragma unroll
            for (int d = 0; d < 4; ++d) yp[d * 32] = (bf16_t)(cvtpk(o[d][r] * rs * sg[d], 0.f) & 0xffffu); }
    }
}
#undef VM_WAIT_LE
#undef SBAR
}
constexpr int NWAVES = 8;
constexpr int DM = 2048, NB = 2, SEQ = 8192, T = NB * SEQ, INW = 13312, ML = 256, NE = 32, FF = 2048, YW = 3072;
constexpr int NBF = 6144, NF8 = INW - NBF;
constexpr int NTILE_MAX = T * 4 / 256 + NE;
constexpr int P = NTILE_MAX * 256;
constexpr float NORM_EPS = 1e-6f;
constexpr float SC_W = 32.f, SC_XS = 8.f, SC_ACT = 4.f;
constexpr int SC_W_BYTE = 0x7a7a7a7a, SC_XS_BYTE = 0x7c7c7c7c, SC_ACT_BYTE = 0x7d7d7d7d;
constexpr size_t MiB = 1u << 20;
constexpr size_t WS_CTL = 0, CTL_ZERO_BYTES = MiB / 4;
constexpr size_t WS_WIN = 1 * MiB;
constexpr size_t WS_WKV = WS_WIN + 54 * MiB;
constexpr size_t WS_WBR = WS_WKV + 9 * MiB;
constexpr size_t WS_WOUT = WS_WBR + 13 * MiB;
constexpr size_t WS_W1 = WS_WOUT + 9 * MiB;
constexpr size_t WS_W2 = WS_W1 + 273 * MiB;
constexpr size_t WS_H = WS_W2 + 137 * MiB;
constexpr size_t WS_MEMN = WS_H + 67 * MiB;
constexpr size_t WS_PROJ = WS_MEMN + 3 * MiB;
constexpr size_t WS_KV = WS_PROJ + 419 * MiB;
constexpr size_t WS_Y = WS_KV + 3 * MiB;
constexpr size_t WS_MERGED = WS_Y + 99 * MiB;
constexpr size_t WS_X1 = WS_MERGED + 67 * MiB;
constexpr size_t WS_XS = WS_X1 + 128 * MiB;
constexpr size_t WS_ACT = WS_XS + 154 * MiB;
constexpr size_t WS_YS = WS_ACT + 154 * MiB;
constexpr size_t WS_ROUTE = WS_YS + 288 * MiB;
constexpr size_t WS_H8 = WS_ROUTE + 2 * MiB;
constexpr size_t WS_WG8 = WS_H8 + 35 * MiB;
constexpr size_t WS_WO8 = WS_WG8 + 28 * MiB;
constexpr size_t WS_END = WS_WO8 + 5 * MiB;
static_assert((size_t)13312 * LD_D * 2 <= 54 * MiB && (size_t)131072 * LD_F8 <= 273 * MiB && (size_t)65536 * LD_F8 <= 137 * MiB && (size_t)16384 * LD_D * 2 <= 67 * MiB && (size_t)16384 * LD_P * 2 <= 419 * MiB && (size_t)16384 * LD_Y * 2 <= 99 * MiB && (size_t)73728 * LD_F8 <= 154 * MiB, "d_ws map");
constexpr size_t RT_RSTD = 0, RT_TOPI = 256 * 1024, RT_TOPG = 512 * 1024, RT_SLOT = 768 * 1024, RT_POS = 1024 * 1024;
constexpr int CW_BAR = 4096, N_BAR_REGIONS = 16;
constexpr int CW_QDIFF = 61440, CW_QSB = 61504, CW_QMEM = 61568, CW_KVDONE = 61632, CW_CNT = 61696, CW_QDX = 62464;
constexpr int RING_BYTES = 131072, LDSCTL_OFF = RING_BYTES, MISC_OFF = LDSCTL_OFF + 320, TAB_OFF = LDSCTL_OFF + 1024;
constexpr int LDS_BYTES = 147456;

#define GAS __attribute__((address_space(1)))
#define LAS __attribute__((address_space(3)))
typedef unsigned short bf16;
typedef unsigned v4u __attribute__((ext_vector_type(4)));
typedef unsigned v2u __attribute__((ext_vector_type(2)));
typedef float f32x4 __attribute__((ext_vector_type(4)));
typedef float f32x16 __attribute__((ext_vector_type(16)));
typedef GAS unsigned gu32;
#define RLX_AGENT __ATOMIC_RELAXED, __HIP_MEMORY_SCOPE_AGENT
#define LDS_WAIT() asm volatile("s_waitcnt lgkmcnt(0)" ::: "memory")
__device__ __forceinline__ unsigned f2bf(float f) { unsigned u = __builtin_bit_cast(unsigned, f); return (u + 0x7fffu + ((u >> 16) & 1u)) >> 16; }
__device__ __forceinline__ unsigned pk2(float lo, float hi) { unsigned r; asm("v_cvt_pk_bf16_f32 %0, %1, %2" : "=v"(r) : "v"(lo), "v"(hi)); return r; }
__device__ __forceinline__ float bf2f(unsigned short v) { return __uint_as_float((unsigned)v << 16); }
__device__ __forceinline__ float wave_sum(float v) {
#pragma unroll
    for (int o = 1; o < 64; o <<= 1) v += __shfl_xor(v, o);
    return v;
}
#define XB_TMO      128
#define XB_XCNT(j)  (256  + 64 * (j))
#define XB_XSUB(j)  (1280 + 64 * (j))
#define XB_XGEN(j)  (2304 + 64 * (j))
#define XB_TOP      3328
#define XB_TOPGEN   3392
#define XCD_BAR_WORDS 3456
#define XB_SPIN_CAP (1u << 18)

__device__ __forceinline__ unsigned xb_ld(unsigned* p)              { return __hip_atomic_load(p, __ATOMIC_RELAXED, __HIP_MEMORY_SCOPE_AGENT); }
__device__ __forceinline__ unsigned xb_add(unsigned* p, unsigned v) { return __hip_atomic_fetch_add(p, v, __ATOMIC_RELAXED, __HIP_MEMORY_SCOPE_AGENT); }
__device__ __forceinline__ unsigned xb_xcc_id() { return (unsigned)__builtin_amdgcn_s_getreg((3 << 11) | 20) & 0xFu; }
#define XB_SPIN(cond, bar) do { unsigned _sp = 0; while (cond) { __builtin_amdgcn_s_sleep(1); \
    if ((++_sp & 255u) == 0u) { if (xb_ld(&(bar)[XB_TMO])) break; if (_sp > XB_SPIN_CAP) { atomicAdd(&(bar)[XB_TMO], 1u); break; } } } } while (0)

struct XcdBarrier {
    unsigned* bar; unsigned x;
    volatile LAS unsigned* st;
};

__device__ __forceinline__ XcdBarrier xcd_barrier_post(unsigned* bar, volatile LAS unsigned* st) {
    XcdBarrier b; b.bar = bar; b.x = xb_xcc_id(); b.st = st;
    if (threadIdx.x == 0) (void)xb_add(&bar[XB_XCNT(b.x)], 1u);
    return b;
}
__device__ __forceinline__ void xcd_barrier_complete(unsigned* bar, unsigned x, unsigned& nloc, unsigned& nx) {
    const unsigned G = gridDim.x * gridDim.y * gridDim.z;
    unsigned sum, cnt, mine, sp = 0u;
    for (;;) {
        sum = 0u; cnt = 0u; mine = 0u;
#pragma unroll
        for (unsigned j = 0; j < 16; ++j) { const unsigned c = xb_ld(&bar[XB_XCNT(j)]); sum += c; cnt += (c > 0u) ? 1u : 0u; mine = (j == x) ? c : mine; }
        if (sum == G) break;
        __builtin_amdgcn_s_sleep(1);
        if ((++sp & 255u) == 0u) { if (xb_ld(&bar[XB_TMO])) break; if (sp > XB_SPIN_CAP) { atomicAdd(&bar[XB_TMO], 1u); break; } }
    }
    nloc = mine > 0u ? mine : 1u; nx = cnt > 0u ? cnt : 1u;
}

__device__ __forceinline__ void xcd_barrier(const XcdBarrier& b) {
    asm volatile("s_waitcnt vmcnt(0)" ::: "memory");
    __syncthreads();
    if (threadIdx.x == 0) {
        unsigned* bar = b.bar;
        __builtin_amdgcn_s_waitcnt(0);
        unsigned nloc = b.st[0], nx = b.st[1];
        if (nloc == 0u) { xcd_barrier_complete(bar, b.x, nloc, nx); b.st[0] = nloc; b.st[1] = nx; }
        const unsigned old = xb_add(&bar[XB_XSUB(b.x)], 1u);
        const unsigned gen = old / nloc;
        if (old + 1u == (gen + 1u) * nloc) {
            __builtin_amdgcn_fence(__ATOMIC_RELEASE, "agent");
            asm volatile("s_waitcnt vmcnt(0)" ::: "memory");
            const unsigned og = xb_add(&bar[XB_TOP], 1u);
            const unsigned tg = og / nx;
            if (og + 1u == (tg + 1u) * nx) xb_add(&bar[XB_TOPGEN], 1u);
            else XB_SPIN(xb_ld(&bar[XB_TOPGEN]) == tg, bar);
            __builtin_amdgcn_fence(__ATOMIC_ACQUIRE, "agent");
            xb_add(&bar[XB_XGEN(b.x)], 1u);
            asm volatile("s_waitcnt vmcnt(0)" ::: "memory");
        } else {
            XB_SPIN(xb_ld(&bar[XB_XGEN(b.x)]) == gen, bar);
            __builtin_amdgcn_fence(__ATOMIC_ACQUIRE, "agent");
            asm volatile("s_waitcnt vmcnt(0)" ::: "memory");
        }
    }
    __syncthreads();
}
__device__ __forceinline__ void p0_transpose_item(const float* W, int N, int k0, int n0, bf16* dst, int ldt, LAS float* scr, int lane) {
#pragma unroll 8
    for (int i = 0; i < 32; ++i) { const int kk = 2 * i + (lane >> 5); scr[kk * 33 + (lane & 31)] = W[(size_t)(k0 + kk) * N + n0 + (lane & 31)]; }
    LDS_WAIT(); asm volatile("" ::: "memory");
    const int c = lane & 7;
#pragma unroll
    for (int j = 0; j < 4; ++j) { const int n = (lane >> 3) + 8 * j; const LAS float* s = scr + (8 * c) * 33 + n;
        v4u o; o.x = pk2(s[0 * 33], s[1 * 33]); o.y = pk2(s[2 * 33], s[3 * 33]); o.z = pk2(s[4 * 33], s[5 * 33]); o.w = pk2(s[6 * 33], s[7 * 33]);
        *(GAS v4u*)(dst + (size_t)n * ldt + 8 * c) = o; }
    LDS_WAIT(); asm volatile("" ::: "memory");
}
__device__ __forceinline__ unsigned pk4_fp8(float a, float b, float c, float d) {
    a = fminf(fmaxf(a, -448.f), 448.f); b = fminf(fmaxf(b, -448.f), 448.f); c = fminf(fmaxf(c, -448.f), 448.f); d = fminf(fmaxf(d, -448.f), 448.f);
    int w = 0; w = __builtin_amdgcn_cvt_pk_fp8_f32(a, b, w, false); w = __builtin_amdgcn_cvt_pk_fp8_f32(c, d, w, true); return (unsigned)w;
}
__device__ __forceinline__ void p0_transpose_item_fp8(const float* W, int N, int k0, int n0, unsigned char* dst, int ldt, float sc, LAS float* scr, int lane) {
#pragma unroll 8
    for (int i = 0; i < 32; ++i) { const int kk = 2 * i + (lane >> 5); scr[kk * 33 + (lane & 31)] = __builtin_nontemporal_load(W + (size_t)(k0 + kk) * N + n0 + (lane & 31)); }
    LDS_WAIT(); asm volatile("" ::: "memory");
    const int c = lane & 3;
#pragma unroll
    for (int j = 0; j < 2; ++j) { const int n = (lane >> 2) + 16 * j; const LAS float* s = scr + (16 * c) * 33 + n;
        v4u o; o.x = pk4_fp8(sc * s[0 * 33], sc * s[1 * 33], sc * s[2 * 33], sc * s[3 * 33]); o.y = pk4_fp8(sc * s[4 * 33], sc * s[5 * 33], sc * s[6 * 33], sc * s[7 * 33]);
        o.z = pk4_fp8(sc * s[8 * 33], sc * s[9 * 33], sc * s[10 * 33], sc * s[11 * 33]); o.w = pk4_fp8(sc * s[12 * 33], sc * s[13 * 33], sc * s[14 * 33], sc * s[15 * 33]);
        *(GAS v4u*)(dst + (size_t)n * ldt + 16 * c) = o; }
    LDS_WAIT(); asm volatile("" ::: "memory");
}
__device__ __forceinline__ void rms_row_to_bf16(const float* xrow, const float* g, bf16* orow, unsigned char* o8row, float sc8, int lane) {
    const GAS f32x4* xr = (const GAS f32x4*)xrow + lane; const GAS f32x4* gr = (const GAS f32x4*)g + lane;
    f32x4 v[8]; float s = 0.f;
#pragma unroll
    for (int j = 0; j < 8; ++j) { v[j] = __builtin_nontemporal_load(xr + 64 * j); s += (v[j].x * v[j].x + v[j].y * v[j].y) + (v[j].z * v[j].z + v[j].w * v[j].w); }
    const float rstd = rsqrtf(wave_sum(s) * (1.f / DM) + NORM_EPS);
    GAS unsigned long long* o8 = (GAS unsigned long long*)orow + lane;
#pragma unroll
    for (int j = 0; j < 8; ++j) { const f32x4 gg = gr[64 * j]; v[j].x *= rstd * gg.x; v[j].y *= rstd * gg.y; v[j].z *= rstd * gg.z; v[j].w *= rstd * gg.w;
        o8[64 * j] = (unsigned long long)pk2(v[j].x, v[j].y) | ((unsigned long long)pk2(v[j].z, v[j].w) << 32); }
    if (o8row) { GAS unsigned* q4 = (GAS unsigned*)o8row + lane;
#pragma unroll
        for (int j = 0; j < 8; ++j) q4[64 * j] = pk4_fp8(v[j].x * sc8, v[j].y * sc8, v[j].z * sc8, v[j].w * sc8); }
}
struct CvtItem { const float* src; unsigned char* dst; int N, ldt; };
__device__ __forceinline__ void cvt_load(const CvtItem& d, int lane, f32x4 (&v)[8]) {
    const float* p = d.src + (size_t)(lane >> 3) * d.N + 4 * (lane & 7);
#pragma unroll
    for (int i = 0; i < 8; ++i) v[i] = __builtin_nontemporal_load((const f32x4*)(p + (size_t)(8 * i) * d.N));
}
__device__ __forceinline__ void cvt_to_lds(const f32x4 (&v)[8], LAS float* scr, int lane) {
    LAS float* s = scr + (lane >> 3) * 33 + 4 * (lane & 7);
#pragma unroll
    for (int i = 0; i < 8; ++i) { s[(8 * i) * 33 + 0] = v[i].x; s[(8 * i) * 33 + 1] = v[i].y; s[(8 * i) * 33 + 2] = v[i].z; s[(8 * i) * 33 + 3] = v[i].w; }
    LDS_WAIT(); asm volatile("" ::: "memory");
}
template <bool FP8> __device__ __forceinline__ void cvt_from_lds(const CvtItem& d, LAS float* scr, int lane, float sc) {
    if (FP8) { const int c = lane & 3;
#pragma unroll
        for (int j = 0; j < 2; ++j) { const int n = (lane >> 2) + 16 * j; const LAS float* s = scr + (16 * c) * 33 + n;
            v4u o; o.x = pk4_fp8(sc * s[0 * 33], sc * s[1 * 33], sc * s[2 * 33], sc * s[3 * 33]); o.y = pk4_fp8(sc * s[4 * 33], sc * s[5 * 33], sc * s[6 * 33], sc * s[7 * 33]);
            o.z = pk4_fp8(sc * s[8 * 33], sc * s[9 * 33], sc * s[10 * 33], sc * s[11 * 33]); o.w = pk4_fp8(sc * s[12 * 33], sc * s[13 * 33], sc * s[14 * 33], sc * s[15 * 33]);
            *(GAS v4u*)(d.dst + (size_t)n * d.ldt + 16 * c) = o; } }
    else { const int c = lane & 7;
#pragma unroll
        for (int j = 0; j < 4; ++j) { const int n = (lane >> 3) + 8 * j; const LAS float* s = scr + (8 * c) * 33 + n;
            v4u o; o.x = pk2(s[0 * 33], s[1 * 33]); o.y = pk2(s[2 * 33], s[3 * 33]); o.z = pk2(s[4 * 33], s[5 * 33]); o.w = pk2(s[6 * 33], s[7 * 33]);
            *(GAS v4u*)(d.dst + (size_t)n * d.ldt + 16 * c) = o; } }
    LDS_WAIT(); asm volatile("" ::: "memory");
}
__device__ __forceinline__ void cvt8_load(const CvtItem& d, int lane, f32x4 (&v)[8]) {
    const float* p = d.src + (size_t)(4 * (lane >> 3)) * d.N + 4 * (lane & 7);
#pragma unroll
    for (int j = 0; j < 4; ++j) { v[j] = __builtin_nontemporal_load((const f32x4*)(p + (size_t)j * d.N)); v[4 + j] = __builtin_nontemporal_load((const f32x4*)(p + (size_t)(32 + j) * d.N)); }
}
__device__ __forceinline__ unsigned pk4_fp8_w(float a, float b, float c, float d) { int w = __float_as_int(a); w = __builtin_amdgcn_cvt_pk_fp8_f32(a, b, w, false); w = __builtin_amdgcn_cvt_pk_fp8_f32(c, d, w, true); return (unsigned)w; }
__device__ __forceinline__ void cvt8_to_lds(const f32x4 (&v)[8], LAS float* scr, int lane, float sc) {
    LAS unsigned* s = (LAS unsigned*)scr + (4 * (lane & 7)) * 18 + (lane >> 3);
#pragma unroll
    for (int nn = 0; nn < 4; ++nn) { s[nn * 18] = pk4_fp8_w(sc * v[0][nn], sc * v[1][nn], sc * v[2][nn], sc * v[3][nn]); s[nn * 18 + 8] = pk4_fp8_w(sc * v[4][nn], sc * v[5][nn], sc * v[6][nn], sc * v[7][nn]); }
    LDS_WAIT(); asm volatile("" ::: "memory");
}
__device__ __forceinline__ void cvt8_from_lds(const CvtItem& d, LAS float* scr, int lane) {
    const int c = lane & 3;
#pragma unroll
    for (int j = 0; j < 2; ++j) { const int n = (lane >> 2) + 16 * j; const LAS v2u* s = (const LAS v2u*)((LAS unsigned*)scr + n * 18 + 4 * c); const v2u lo = s[0], hi = s[1];
        *(GAS v4u*)(d.dst + (size_t)n * d.ldt + 16 * c) = (v4u){lo.x, lo.y, hi.x, hi.y}; }
    LDS_WAIT(); asm volatile("" ::: "memory");
}
__device__ __forceinline__ void cvt16_to_lds(const f32x4 (&v)[8], LAS float* scr, int lane) {
    LAS v2u* s = (LAS v2u*)((LAS unsigned*)scr + (4 * (lane & 7)) * 36 + 2 * (lane >> 3));
#pragma unroll
    for (int nn = 0; nn < 4; ++nn) { s[nn * 18] = (v2u){pk2(v[0][nn], v[1][nn]), pk2(v[2][nn], v[3][nn])}; s[nn * 18 + 8] = (v2u){pk2(v[4][nn], v[5][nn]), pk2(v[6][nn], v[7][nn])}; }
    LDS_WAIT(); asm volatile("" ::: "memory");
}
__device__ __forceinline__ void cvt16_from_lds(const CvtItem& d, LAS float* scr, int lane) {
    const int c = lane & 7;
#pragma unroll
    for (int j = 0; j < 4; ++j) { const int n = (lane >> 3) + 8 * j; *(GAS v4u*)(d.dst + (size_t)n * d.ldt + 16 * c) = *(const LAS v4u*)((LAS unsigned*)scr + n * 36 + 4 * c); }
    LDS_WAIT(); asm volatile("" ::: "memory");
}
template <bool FP8, class DEC> __device__ __forceinline__ void cvt_run(const DEC& dec, int first, int stride, int count, LAS float* scr, int lane, float sc) {
    if (count <= 0) return;
    f32x4 v0[8], v1[8], v2[8]; CvtItem d0 = dec(first), d1 = d0, d2 = d0;
#define CVT_LOAD(D, V) cvt8_load(D, lane, V)
    CVT_LOAD(d0, v0);
    if (count > 1) { d1 = dec(first + stride); CVT_LOAD(d1, v1); }
    if (count > 2) { d2 = dec(first + 2 * stride); CVT_LOAD(d2, v2); }
#define CVT_STEP(V, D, NXT) do { if constexpr (FP8) cvt8_to_lds(V, scr, lane, sc); else cvt16_to_lds(V, scr, lane); const CvtItem cur_ = D; if ((NXT) < count) { D = dec(first + (NXT) * stride); CVT_LOAD(D, V); } \
        if constexpr (FP8) cvt8_from_lds(cur_, scr, lane); else cvt16_from_lds(cur_, scr, lane); } while (0)
    for (int i = 0; i < count; i += 3) {
        CVT_STEP(v0, d0, i + 3);
        if (i + 1 < count) CVT_STEP(v1, d1, i + 4);
        if (i + 2 < count) CVT_STEP(v2, d2, i + 5);
    }
#undef CVT_STEP
#undef CVT_LOAD
}
struct CvtTile { const float* src; unsigned char* dst; int N; };
constexpr int CVT_IMG_BYTES = 128 * 33 * 4;
__device__ __forceinline__ void cvtt_load(const CvtTile& d, int wave, int lane, f32x4 (&v)[8]) {
    const float* p = d.src + (size_t)(16 * wave + 4 * (lane >> 4)) * d.N + 4 * (lane & 15);
#pragma unroll
    for (int ps = 0; ps < 2; ++ps)
#pragma unroll
        for (int j = 0; j < 4; ++j) v[ps * 4 + j] = __builtin_nontemporal_load((const f32x4*)(p + (size_t)j * d.N + 64 * ps));
}
template <class DEC> __device__ __forceinline__ void cvt_wg(const DEC& dec, int first, int count, LAS unsigned char* lds, int wave, int lane, float sc) {
    if (count <= 0) return;
    const int tid = wave * 64 + lane;
    f32x4 va[8], vb[8], vc[8], vd[8]; CvtTile d0 = dec(first), d1 = d0, d2 = d0, d3 = d0;
    cvtt_load(d0, wave, lane, va);
    if (count > 1) { d1 = dec(first + 1); cvtt_load(d1, wave, lane, vb); }
    if (count > 2) { d2 = dec(first + 2); cvtt_load(d2, wave, lane, vc); }
    if (count > 3) { d3 = dec(first + 3); cvtt_load(d3, wave, lane, vd); }
#define CVTT_STEP(V, D, NXT, B) do { LAS unsigned* img = (LAS unsigned*)(lds + (B) * CVT_IMG_BYTES); { LAS unsigned* wp = img + (4 * (lane & 15)) * 33 + 4 * wave + (lane >> 4); \
            _Pragma("unroll") for (int ps = 0; ps < 2; ++ps) _Pragma("unroll") for (int nn = 0; nn < 4; ++nn) \
                wp[(64 * ps + nn) * 33] = pk4_fp8_w(sc * V[ps * 4 + 0][nn], sc * V[ps * 4 + 1][nn], sc * V[ps * 4 + 2][nn], sc * V[ps * 4 + 3][nn]); } \
        const CvtTile cur_ = D; if ((NXT) < count) { D = dec(first + (NXT)); cvtt_load(D, wave, lane, V); } \
        __syncthreads(); \
        _Pragma("unroll") for (int r = 0; r < 2; ++r) { const int q = tid + 512 * r, n = q >> 3, part = q & 7; const LAS unsigned* sp = img + n * 33 + 4 * part; \
            __builtin_nontemporal_store((v4u){sp[0], sp[1], sp[2], sp[3]}, (GAS v4u*)(cur_.dst + (size_t)n * LD_F8 + 16 * part)); } } while (0)
    for (int i = 0; i < count; i += 4) {
        CVTT_STEP(va, d0, i + 4, 0);
        if (i + 1 < count) CVTT_STEP(vb, d1, i + 5, 1);
        if (i + 2 < count) CVTT_STEP(vc, d2, i + 6, 0);
        if (i + 3 < count) CVTT_STEP(vd, d3, i + 7, 1);
    }
#undef CVTT_STEP
    __syncthreads();
}
#ifndef CVT_IN_P0
#define CVT_IN_P0 0
#endif
#ifndef P4_FP8
#define P4_FP8 0
#endif
#ifndef F8_VTILES
#define F8_VTILES 0x00F00F00ull
#endif
constexpr unsigned long long F8_TILES = (F8_VTILES) | 0xFFFFFFF000000ull, BF_TILES = 0xFFFFFFull & ~(unsigned long long)(F8_VTILES);
constexpr int NT_F8 = __builtin_popcountll(F8_TILES), NT_BF = __builtin_popcountll(BF_TILES);
struct P0Dec {
    const float *w_in, *w_kv, *w_bd, *w_bs, *w_bm, *w_out; bf16 *Wt_in, *Wt_kv, *Wt_br, *Wt_out;
    __device__ __forceinline__ CvtItem operator()(int r) const {
        constexpr int I_IN = 32 * (8 * NT_BF), I_KV = 32 * 64, I_BR = 16 * 64;
        const float* src; unsigned char* dst; int N = 2048, ldt = LD_D * 2;
        if (r < I_IN) { const int nblk = 8 * NT_BF, k0 = 64 * (r / nblk), nb = r % nblk, n0 = 256 * pg8::nth_bit(BF_TILES, nb >> 3) + 32 * (nb & 7); src = w_in + (size_t)k0 * INW + n0; dst = (unsigned char*)(Wt_in + (size_t)n0 * LD_D + k0); N = INW; }
        else if (r < I_IN + I_KV) { r -= I_IN; const int k0 = 64 * (r / 64), n0 = 32 * (r % 64); src = w_kv + (size_t)k0 * 2048 + n0; dst = (unsigned char*)(Wt_kv + (size_t)n0 * LD_D + k0); }
        else if (r < I_IN + I_KV + I_BR) { r -= I_IN + I_KV; const int k0 = 64 * (r / 64), n0 = 32 * (r % 64); src = w_bd + (size_t)k0 * 2048 + n0; dst = (unsigned char*)(Wt_br + (size_t)n0 * LD_Y + k0); ldt = LD_Y * 2; }
        else if (r < I_IN + I_KV + 2 * I_BR) { r -= I_IN + I_KV + I_BR; const int k0 = 64 * (r / 64), n0 = 32 * (r % 64); src = w_bs + (size_t)k0 * 2048 + n0; dst = (unsigned char*)(Wt_br + (size_t)n0 * LD_Y + 1024 + k0); ldt = LD_Y * 2; }
        else if (r < I_IN + I_KV + 3 * I_BR) { r -= I_IN + I_KV + 2 * I_BR; const int k0 = 64 * (r / 64), n0 = 32 * (r % 64); src = w_bm + (size_t)k0 * 2048 + n0; dst = (unsigned char*)(Wt_br + (size_t)n0 * LD_Y + 2048 + k0); ldt = LD_Y * 2; }
        else { r -= I_IN + I_KV + 3 * I_BR; const int k0 = 64 * (r / 64), n0 = 32 * (r % 64); src = w_out + (size_t)k0 * 2048 + n0; dst = (unsigned char*)(Wt_out + (size_t)n0 * LD_D + k0); }
        return CvtItem{src, dst, N, ldt};
    }
};
#ifndef MK_ATT
#define MK_ATT 15
#endif
struct Args {
    const float* in[25]; float* out; unsigned char* ws; int ph_lo, ph_hi, li, pad;
};
constexpr int N_PHASES = 10;

__device__ __forceinline__ int dequeue(gu32* head, volatile LAS int* slot) {
    __syncthreads();
    if (threadIdx.x == 0) *slot = (int)__hip_atomic_fetch_add(head, 1u, RLX_AGENT);
    __syncthreads();
    return *slot;
}
__device__ __forceinline__ int dequeue_diff(gu32* qbase, int bx, volatile LAS int* slot, int& qx) {
    __syncthreads();
    if (threadIdx.x < 64) { const int lane = threadIdx.x; int li = -1, q = bx & 7;
        unsigned got = 0; if (lane == 0) got = __hip_atomic_fetch_add(qbase + 16 * q, 1u, RLX_AGENT);
        got = (unsigned)__builtin_amdgcn_readfirstlane((int)got);
        if (got < 128u) li = (int)got;
        else for (;;) {
            const unsigned h = (lane >= 1 && lane < 8) ? __hip_atomic_load(qbase + 16 * ((bx + lane) & 7), RLX_AGENT) : 128u;
            const unsigned long long m = __ballot(h < 128u);
            if (m == 0ull) break;
            q = (bx + (__ffsll((long long)m) - 1)) & 7;
            got = 0; if (lane == 0) got = __hip_atomic_fetch_add(qbase + 16 * q, 1u, RLX_AGENT);
            got = (unsigned)__builtin_amdgcn_readfirstlane((int)got);
            if (got < 128u) { li = (int)got; break; }
        }
        if (lane == 0) { slot[0] = li; slot[1] = q; } }
    __syncthreads();
    qx = slot[1]; return slot[0];
}
__device__ __forceinline__ void build_tile0(const gu32* cnt, volatile LAS int* tile0) {
    __syncthreads();
    if (threadIdx.x < 64) {
        const int lane = threadIdx.x; int t = 0; if (lane < NE) t = ((int)__hip_atomic_load(cnt + lane, RLX_AGENT) + 255) >> 8;
        int incl = t;
#pragma unroll
        for (int o = 1; o < 32; o <<= 1) { const int v = __shfl_up(incl, o); if (lane >= o) incl += v; }
        if (lane < NE) tile0[lane] = incl - t;
        if (lane == NE - 1) tile0[NE] = incl; }
    __syncthreads();
}

__device__ __forceinline__ void moe_fill_tab(volatile LAS int* tile0, volatile LAS int* tab, int nN, int G, int c) {
    if (threadIdx.x < 32) { const int i = threadIdx.x, L = i * G + c; int pm = -1, pn = 0;
        if (L < tile0[NE] * nN) { int e = 0; for (int k = 1; k < NE; ++k) e += (L >= tile0[k] * nN) ? 1 : 0;
            const int t0 = tile0[e], me = tile0[e + 1] - t0, rem = L - t0 * nN; pm = t0 + rem % me; pn = e * nN + rem / me; }
        tab[2 * i] = pm; tab[2 * i + 1] = pn; }
    __syncthreads();
}

template <class SCH> __device__ __forceinline__ void order_fill_tab(const SCH& S, volatile LAS int* tab) {
    __syncthreads();
    if (threadIdx.x < 32) { pg8::Unit u{0, 0}; const bool ok = S.next((int)threadIdx.x, u); tab[2 * threadIdx.x] = ok ? u.pm : -1; tab[2 * threadIdx.x + 1] = u.pn; }
    __syncthreads();
}

__global__ void __launch_bounds__(NWAVES * 64, 2) fwd_kernel(Args args) {
    extern __shared__ __attribute__((aligned(16))) unsigned char lds_raw[];
    LAS unsigned char* lds = (LAS unsigned char*)lds_raw;
    volatile LAS unsigned* MISC = (volatile LAS unsigned*)(lds + MISC_OFF);
    volatile LAS int* tile0 = (volatile LAS int*)(lds + TAB_OFF);
    volatile LAS int* dq_slot = (volatile LAS int*)(lds + TAB_OFF + 256);
    const int tid = threadIdx.x, lane = tid & 63, wave = __builtin_amdgcn_readfirstlane(tid >> 6);
    const int G = gridDim.x; const int bx = blockIdx.x; const int vcu = (G % 8 == 0) ? (bx % 8) * (G / 8) + bx / 8 : bx;
    unsigned char* ws = args.ws;
    gu32* ctl = (gu32*)(ws + WS_CTL);
    const float* x = args.in[0]; const float* mem = args.in[1]; const float* g_mix = args.in[2]; const float* w_in = args.in[3]; const float* b_gate = args.in[4];
    const float* rel_bias = args.in[5]; const float* lq1 = args.in[6]; const float* lk1 = args.in[7]; const float* lq2 = args.in[8]; const float* lk2 = args.in[9];
    const float* subg = args.in[10]; const float* g_mem = args.in[11]; const float* w_kv = args.in[12]; const float* w_bd = args.in[13]; const float* w_bs = args.in[14];
    const float* w_bm = args.in[15]; const float* w_out = args.in[16]; const float* g_ffn = args.in[17]; const float* w_r = args.in[18]; const float* b_r = args.in[19];
    const float* w1 = args.in[20]; const float* b1 = args.in[21]; const float* w2 = args.in[22]; const float* b2 = args.in[23]; const float* g_final = args.in[24];
    bf16* Wt_in = (bf16*)(ws + WS_WIN); bf16* Wt_kv = (bf16*)(ws + WS_WKV); bf16* Wt_br = (bf16*)(ws + WS_WBR); bf16* Wt_out = (bf16*)(ws + WS_WOUT);
    bf16* Wt_1 = (bf16*)(ws + WS_W1); bf16* Wt_2 = (bf16*)(ws + WS_W2);
    bf16* Hb = (bf16*)(ws + WS_H); bf16* MemN = (bf16*)(ws + WS_MEMN); bf16* Proj = (bf16*)(ws + WS_PROJ); bf16* KV = (bf16*)(ws + WS_KV); bf16* Yb = (bf16*)(ws + WS_Y);
    bf16* Merged = (bf16*)(ws + WS_MERGED); float* X1 = (float*)(ws + WS_X1); bf16* XS = (bf16*)(ws + WS_XS); bf16* ACT = (bf16*)(ws + WS_ACT); bf16* YS = (bf16*)(ws + WS_YS);
    unsigned char* H8 = ws + WS_H8; unsigned char* Wg8 = ws + WS_WG8;
    float* r_rstd = (float*)(ws + WS_ROUTE + RT_RSTD); int* r_topi = (int*)(ws + WS_ROUTE + RT_TOPI); float* r_topg = (float*)(ws + WS_ROUTE + RT_TOPG);
    int* r_slot = (int*)(ws + WS_ROUTE + RT_SLOT); int* r_pos = (int*)(ws + WS_ROUTE + RT_POS);

    for (int u = tid; u < (LDS_BYTES - LDSCTL_OFF) / 4; u += NWAVES * 64) ((LAS unsigned*)(lds + LDSCTL_OFF))[u] = 0u;
    __syncthreads();
    XcdBarrier bar = xcd_barrier_post((unsigned*)(ctl + CW_BAR) + args.li * XCD_BAR_WORDS, MISC + 8);
    const int lo = args.ph_lo, hi = args.ph_hi;
#ifndef MK_PHMASK
#define MK_PHMASK 0x3ffu
#endif
#define IN(k) ((((MK_PHMASK) >> (k)) & 1u) && lo <= (k) && (k) < hi)
#define SEAM(k) do { if (IN(k) && IN((k) + 1)) xcd_barrier(bar); } while (0)
    const int gw = vcu * NWAVES + wave, NGW = G * NWAVES;

    if (IN(0)) {
        LAS float* scr = (LAS float*)(lds + wave * 16384);
        constexpr int I_IN = 32 * (8 * NT_BF), I_KV = 32 * 64, I_BR = 16 * 64, I_OUT = 32 * 64, I_G8 = 32 * (8 * NT_F8);
        constexpr int NITEMS = I_IN + I_KV + 3 * I_BR + I_OUT;
        const P0Dec dec{w_in, w_kv, w_bd, w_bs, w_bm, w_out, Wt_in, Wt_kv, Wt_br, Wt_out};
        cvt_run<false>(dec, gw, NGW, (NITEMS - gw + NGW - 1) / NGW, scr, lane, 1.f);
        {   auto decg = [=](int r) -> CvtItem { const int k0 = 64 * (r / (8 * NT_F8)), nb = r % (8 * NT_F8), n0 = 256 * pg8::nth_bit(F8_TILES, nb >> 3) + 32 * (nb & 7);
                return CvtItem{w_in + (size_t)k0 * INW + n0, Wg8 + (size_t)n0 * LD_F8 + k0, INW, LD_F8}; };
            cvt_run<true>(decg, gw, NGW, (I_G8 - gw + NGW - 1) / NGW, scr, lane, SC_W); }
#if defined(PROBE_REP) && PROBE_REP == 0
        cvt_run<false>(dec, gw, NGW, (NITEMS - gw + NGW - 1) / NGW, scr, lane, 1.f);
        for (int m = gw; m < T; m += NGW) rms_row_to_bf16(x + (size_t)m * DM, g_mix, Hb + (size_t)m * LD_D, H8 + (size_t)m * LD_F8, SC_XS, lane);
#endif
#if CVT_IN_P0
        {   constexpr int J_E1 = 32 * 128, J_E2 = 32 * 64, NEI = NE * J_E1 + NE * J_E2;
            auto dece = [=](int r) -> CvtItem {
                if (r < NE * J_E1) { const int e = r / J_E1, q = r % J_E1, k0 = 64 * (q / 128), n0 = 32 * (q % 128);
                    const int nn = n0 & 2047, drow = (nn >> 7) * 256 + (n0 >= 2048 ? 128 : 0) + (nn & 127);
                    return CvtItem{w1 + (size_t)e * DM * 4096 + (size_t)k0 * 4096 + n0, (unsigned char*)Wt_1 + ((size_t)e * 4096 + drow) * LD_F8 + k0, 4096, LD_F8}; }
                r -= NE * J_E1; const int e = r / J_E2, q = r % J_E2, k0 = 64 * (q / 64), n0 = 32 * (q % 64);
                return CvtItem{w2 + (size_t)e * FF * DM + (size_t)k0 * 2048 + n0, (unsigned char*)Wt_2 + ((size_t)e * 2048 + n0) * LD_F8 + k0, 2048, LD_F8}; };
            cvt_run<true>(dece, gw, NGW, NEI / NGW, scr, lane, SC_W); }
#endif
#if P4_FP8
        {   unsigned char* Wo8 = ws + WS_WO8; auto deco = [=](int r) -> CvtItem { const int k0 = 64 * (r / 64), n0 = 32 * (r % 64); return CvtItem{w_out + (size_t)k0 * 2048 + n0, Wo8 + (size_t)n0 * LD_F8 + k0, 2048, LD_F8}; };
            cvt_run<true>(deco, gw, NGW, (2048 - gw + NGW - 1) / NGW, scr, lane, SC_W); }
#endif
        for (int m = gw; m < T; m += NGW) rms_row_to_bf16(x + (size_t)m * DM, g_mix, Hb + (size_t)m * LD_D, H8 + (size_t)m * LD_F8, SC_XS, lane);
        for (int m = gw; m < NB * ML; m += NGW) rms_row_to_bf16(mem + (size_t)m * DM, g_mem, MemN + (size_t)m * LD_D, nullptr, 1.f, lane);
    }
    if (IN(0) && IN(1)) {
        pg8::GateOrder Sa; Sa.S.init(T, 256 * NT_BF, G, bx); Sa.mask = BF_TILES; order_fill_tab(Sa, tile0 + 128);
        pg8::GateOrder Sb; Sb.S.init(T, 256 * NT_F8, G, bx); Sb.mask = F8_TILES; order_fill_tab(Sb, tile0 + 192); }
    SEAM(0);
    if (IN(1)) {
        {   pg8::Gemm g{Hb, Wt_in, T, INW, DM, 0, 0, LD_D, LD_D}; pg8::MoeTabOrder S{(const LAS int*)tile0 + 128};
            pg8::EpiProjQ E{Proj, b_gate};
            pg8::gemm_phase<pg8::EpiProjQ, pg8::MoeTabOrder, true, true>(lds, g, S, E); }
        {
            pg8::Gemm g{(const bf16*)H8, (const bf16*)Wg8, T, INW, DM / 2, SC_XS_BYTE, SC_W_BYTE, LD_F8 / 2, LD_F8 / 2}; pg8::MoeTabOrder S{(const LAS int*)tile0 + 192};
            pg8::EpiProj E{Proj, b_gate};
            pg8::gemm_phase<pg8::EpiProj, pg8::MoeTabOrder, true, true, true, true>(lds, g, S, E); }
    }
    SEAM(1);
    if (IN(2)) {
        if (MK_ATT & 8) {   pg8::Gemm g{MemN, Wt_kv, NB * ML, 2048, DM, 0, 0, LD_D, LD_D}; pg8::KvOrder S{bx};
            pg8::EpiBf16<0> E{KV, LD_D, nullptr, 0, 0, 1.f};
            pg8::gemm_phase<pg8::EpiBf16<0>, pg8::KvOrder, false, true>(lds, g, S, E);
            if (bx < 16) {
                asm volatile("s_waitcnt vmcnt(0)" ::: "memory"); __syncthreads();
                if (tid == 0) { __builtin_amdgcn_fence(__ATOMIC_RELEASE, "agent"); asm volatile("s_waitcnt vmcnt(0)" ::: "memory"); __hip_atomic_fetch_add(ctl + CW_KVDONE, 1u, RLX_AGENT); }
            }
        }
        float s1 = 0.f, s2 = 0.f;
        for (int i = 0; i < 64; ++i) { s1 += lq1[i] * lk1[i]; s2 += lq2[i] * lk2[i]; }
        const att::AttnIO io{Proj, KV, Yb, rel_bias, subg, expf(s1) - expf(s2) + 0.2f};
        const att::CvCtx cvx{w1, w2, (unsigned char*)Wt_1, (unsigned char*)Wt_2, SC_W};
        if (MK_ATT & 1) for (;;) { int qx = 0; int idx = dequeue_diff(ctl + CW_QDX, bx, dq_slot, qx);
            if (idx < 0) break;
            const int qb = 63 - (idx & 63), bh = 2 * qx + (idx >> 6); idx += 128 * qx;
            constexpr int T_E1 = 16 * 32, T_E2 = 16 * 16, CHT = (NE * T_E1 + NE * T_E2) / 1024;
            auto dect = [=](int t) -> CvtTile {
                if (t < NE * T_E1) { const int e = t / T_E1, q = t % T_E1, k0 = 128 * (q / 32), n0 = 128 * (q % 32); const int nn = n0 & 2047, drow = (nn >> 7) * 256 + (n0 >= 2048 ? 128 : 0);
                    return CvtTile{w1 + (size_t)e * DM * 4096 + (size_t)k0 * 4096 + n0, (unsigned char*)Wt_1 + ((size_t)e * 4096 + drow) * LD_F8 + k0, 4096}; }
                const int t2 = t - NE * T_E1, e = t2 / T_E2, q = t2 % T_E2, k0 = 128 * (q / 16), n0 = 128 * (q % 16);
                return CvtTile{w2 + (size_t)e * FF * DM + (size_t)k0 * 2048 + n0, (unsigned char*)Wt_2 + ((size_t)e * 2048 + n0) * LD_F8 + k0, 2048}; };
            const int nA = 6 * ((bx >> 3) & 3);
            __syncthreads();
            cvt_wg(dect, idx * CHT, nA, lds, wave, lane, SC_W);
            att::attn_unit_diff2(io, bh >> 3, bh & 7, qb, (LAS char*)lds);
            __syncthreads();
            cvt_wg(dect, idx * CHT + nA, CHT - nA, lds, wave, lane, SC_W);
        }
#ifdef PROBE_DIFF_TWICE
        for (;;) { int idx = -1, qx = 0;
            for (int s = 0; s < 8 && idx < 0; ++s) { qx = (bx + s) & 7; const int li = dequeue(ctl + CW_QDX + 128 + 16 * qx, dq_slot); if (li < 128) idx = li; }
            if (idx < 0) break;
            const int qb = 63 - (idx & 63), bh = 2 * qx + (idx >> 6);
            att::attn_unit_diff2(io, bh >> 3, bh & 7, qb, (LAS char*)lds); }
#endif
        if (MK_ATT & 2) for (;;) { const int idx = dequeue(ctl + CW_QSB, dq_slot); if (idx >= 16 * 32) break;
            const int qb = 31 - idx / 16, bh = idx % 16; att::attn_unit<att::SB>(io, bh >> 3, bh & 7, qb, 0, (LAS char*)lds); }
        if (tid == 0) { unsigned sp = 0; while (__hip_atomic_load(ctl + CW_KVDONE, RLX_AGENT) < 16u) { __builtin_amdgcn_s_sleep(2); if (++sp > (1u << 22)) break; }
            __builtin_amdgcn_fence(__ATOMIC_ACQUIRE, "agent"); asm volatile("s_waitcnt vmcnt(0)" ::: "memory"); }
        __syncthreads();
        if (MK_ATT & 4) for (;;) { const int idx = dequeue(ctl + CW_QMEM, dq_slot); if (idx >= 2 * 4 * 2 * 32) break;
            const int qb = idx & 31, vh = (idx >> 5) & 1, hd = (idx >> 6) & 3, b = idx >> 8; att::attn_unit<att::MEM>(io, b, hd, qb, vh, (LAS char*)lds); }
        __syncthreads();
#ifdef PROBE_SBMEM_TWICE
        for (;;) { const int idx = dequeue(ctl + CW_QSB + 16, dq_slot); if (idx >= 16 * 32) break;
            const int qb = 31 - idx / 16, bh = idx % 16; att::attn_unit<att::SB>(io, bh >> 3, bh & 7, qb, 0, (LAS char*)lds); }
        for (;;) { const int idx = dequeue(ctl + CW_QMEM + 16, dq_slot); if (idx >= 2 * 4 * 2 * 32) break;
            const int qb = idx & 31, vh = (idx >> 5) & 1, hd = (idx >> 6) & 3, b = idx >> 8; att::attn_unit<att::MEM>(io, b, hd, qb, vh, (LAS char*)lds); }
        __syncthreads();
#endif
    }
    if (IN(2) && IN(3)) { pg8::StaticOrder Sa; Sa.init(T, DM, G, bx); order_fill_tab(Sa, tile0 + 128); }
    SEAM(2);
    if (IN(3)) {
        pg8::Gemm g{Yb, Wt_br, T, DM, 3072, 0, 0, LD_Y, LD_Y}; pg8::MoeTabOrder S{(const LAS int*)tile0 + 128};
#if P4_FP8
        pg8::EpiMerged8 E{Merged, Proj + 7168};
        pg8::gemm_phase<pg8::EpiMerged8, pg8::StaticOrder, true, true>(lds, g, S, E);
#else
        pg8::EpiMerged E{Merged, Proj + 7168};
        pg8::gemm_phase<pg8::EpiMerged, pg8::MoeTabOrder, true, true>(lds, g, S, E);
#endif
#if defined(PROBE_REP) && (PROBE_REP == 34 || PROBE_REP == 3)
        __syncthreads(); pg8::gemm_phase<pg8::EpiMerged, pg8::StaticOrder, true, true>(lds, g, S, E);
#endif
    }
    SEAM(3);
    if (IN(4)) {
#if P4_FP8
        pg8::Gemm g{Merged, (const bf16*)(ws + WS_WO8), T, DM, DM / 2, 0x7b7b7b7b, SC_W_BYTE, LD_F8 / 2, LD_F8 / 2}; pg8::StaticOrder S; S.init(T, DM, G, bx);
        pg8::EpiResid E{x, X1};
        pg8::gemm_phase<pg8::EpiResid, pg8::StaticOrder, true, true, true>(lds, g, S, E);
#else
        pg8::Gemm g{Merged, Wt_out, T, DM, DM, 0, 0, LD_D, LD_D}; pg8::MoeTabOrder S{(const LAS int*)tile0 + 128};
        pg8::EpiResid E{x, X1};
#ifndef P4_STAGGER
#define P4_STAGGER 2
#endif
        if ((bx >> 3) & 1) { for (int i = 0; i < P4_STAGGER; ++i) __builtin_amdgcn_s_sleep(127); }
        pg8::gemm_phase<pg8::EpiResid, pg8::MoeTabOrder, true, true>(lds, g, S, E);
#endif
#if defined(PROBE_REP) && PROBE_REP == 34
        __syncthreads(); pg8::gemm_phase<pg8::EpiResid, pg8::StaticOrder, true, true>(lds, g, S, E);
#endif
    }
    SEAM(4);
    if (IN(5)) {
        const int i32 = lane & 31, kh = lane >> 5, kq = wave & 3, hg = wave >> 2;
        LAS float* part = (LAS float*)lds;
        for (int gb = 2 * vcu; gb < T / 32; gb += 2 * G) {
            const int grp = gb + hg, t0 = grp * 32; const float* xrow = X1 + (size_t)(t0 + i32) * DM + kq * 512 + 16 * kh;
            const float* wrow = w_r + (size_t)(kq * 512 + 16 * kh) * NE + i32; const float* grow = g_ffn + kq * 512 + 16 * kh;
            f32x16 acc = {}; float ss = 0.f;
            f32x4 xa[4], ga[4], xb[4], gb4[4]; float wa[16], wb[16];
#define P5_LOAD(XV, GV, WV, s) do { _Pragma("unroll") for (int q = 0; q < 4; ++q) { XV[q] = *(const f32x4*)(xrow + (s) * 32 + 4 * q); GV[q] = *(const f32x4*)(grow + (s) * 32 + 4 * q); } \
                _Pragma("unroll") for (int q = 0; q < 16; ++q) WV[q] = wrow[(size_t)((s) * 32 + q) * NE]; } while (0)
#define P5_MMA(XV, GV, WV) do { _Pragma("unroll") for (int q = 0; q < 4; ++q) _Pragma("unroll") for (int j = 0; j < 4; ++j) { const float b = XV[q][j]; ss += b * b; \
                acc = __builtin_amdgcn_mfma_f32_32x32x2f32(WV[4 * q + j] * GV[q][j], b, acc, 0, 0, 0); } } while (0)
            P5_LOAD(xa, ga, wa, 0);
#pragma unroll 1
            for (int s = 0; s < 16; s += 2) {
                P5_LOAD(xb, gb4, wb, s + 1);
                P5_MMA(xa, ga, wa);
                if (s + 2 < 16) P5_LOAD(xa, ga, wa, s + 2);
                P5_MMA(xb, gb4, wb);
            }
#undef P5_LOAD
#undef P5_MMA
            __syncthreads();
#pragma unroll
            for (int r = 0; r < 16; ++r) part[(wave * 17 + r) * 64 + lane] = acc[r];
            part[(wave * 17 + 16) * 64 + lane] = ss;
            __syncthreads();
            if (kq == 0 && grp < T / 32) {
#pragma unroll
                for (int r = 0; r < 16; ++r) acc[r] = (part[((wave + 0) * 17 + r) * 64 + lane] + part[((wave + 1) * 17 + r) * 64 + lane]) + (part[((wave + 2) * 17 + r) * 64 + lane] + part[((wave + 3) * 17 + r) * 64 + lane]);
                ss = (part[((wave + 0) * 17 + 16) * 64 + lane] + part[((wave + 1) * 17 + 16) * 64 + lane]) + (part[((wave + 2) * 17 + 16) * 64 + lane] + part[((wave + 3) * 17 + 16) * 64 + lane]);
                ss = att::swap_sum(ss);
                const float rstd = rsqrtf(ss * (1.f / DM) + NORM_EPS);
                float v[16];
#pragma unroll
                for (int r = 0; r < 16; ++r) v[r] = acc[r] * rstd + b_r[att::crow(r, kh)];
                float cv[8]; int ci[8];
#pragma unroll
                for (int k = 0; k < 4; ++k) { float best = -3.0e38f; int idx = 64;
#pragma unroll
                    for (int r = 0; r < 16; ++r) { const int e = att::crow(r, kh); const bool better = v[r] > best || (v[r] == best && e < idx); best = better ? v[r] : best; idx = better ? e : idx; }
#pragma unroll
                    for (int r = 0; r < 16; ++r) if (att::crow(r, kh) == idx) v[r] = -3.0e38f;
                    cv[k] = best; ci[k] = idx; }
#pragma unroll
                for (int k = 0; k < 4; ++k) { cv[4 + k] = att::other_half(cv[k]); ci[4 + k] = __float_as_int(att::other_half(__int_as_float(ci[k]))); }
                float tv[4]; int ti[4];
#pragma unroll
                for (int k = 0; k < 4; ++k) { float best = -3.0e38f; int idx = 64;
#pragma unroll
                    for (int c = 0; c < 8; ++c) { const bool better = cv[c] > best || (cv[c] == best && ci[c] < idx); best = better ? cv[c] : best; idx = better ? ci[c] : idx; }
#pragma unroll
                    for (int c = 0; c < 8; ++c) if (ci[c] == idx) cv[c] = -3.0e38f;
                    tv[k] = best; ti[k] = idx; }
                const float e1 = expf(tv[1] - tv[0]), e2 = expf(tv[2] - tv[0]), e3 = expf(tv[3] - tv[0]), inv = 1.0f / (1.0f + e1 + e2 + e3);
                if (kh == 0) { const int t = t0 + i32; r_rstd[t] = rstd;
                    r_topg[t * 4 + 0] = inv; r_topg[t * 4 + 1] = e1 * inv; r_topg[t * 4 + 2] = e2 * inv; r_topg[t * 4 + 3] = e3 * inv;
#pragma unroll
                    for (int k = 0; k < 4; ++k) { r_topi[t * 4 + k] = ti[k]; r_slot[t * 4 + k] = (int)__hip_atomic_fetch_add(ctl + CW_CNT + ti[k], 1u, RLX_AGENT); } }
            }
        }
    }
    SEAM(5);
    if (IN(6)) {
        build_tile0(ctl + CW_CNT, tile0);
#if defined(PROBE_REP) && PROBE_REP == 69
        for (int rep = 0; rep < 2; ++rep)
#endif
        for (int t = gw; t < T; t += NGW) {
            const GAS f32x4* xr = (const GAS f32x4*)(X1 + (size_t)t * DM) + lane; const GAS f32x4* gr = (const GAS f32x4*)g_ffn + lane; const float rstd = r_rstd[t];
            unsigned w[8];
#pragma unroll
            for (int j = 0; j < 8; ++j) { const f32x4 v = __builtin_nontemporal_load(xr + 64 * j), gg = gr[64 * j]; const float s = rstd * SC_XS; w[j] = pk4_fp8(v.x * s * gg.x, v.y * s * gg.y, v.z * s * gg.z, v.w * s * gg.w); }
#pragma unroll
            for (int k = 0; k < 4; ++k) { const int e = r_topi[t * 4 + k], dest = tile0[e] * 256 + r_slot[t * 4 + k];
                GAS unsigned* o4 = (GAS unsigned*)((unsigned char*)XS + (size_t)dest * LD_F8) + lane;
#pragma unroll
                for (int j = 0; j < 8; ++j) __builtin_nontemporal_store(w[j], o4 + 64 * j);
                if (lane == 0) r_pos[t * 4 + k] = dest; }
        }
    }
    if (IN(6) && IN(7)) moe_fill_tab(tile0, tile0 + 128, 16, G, vcu);
    SEAM(6);
    if (IN(7)) {
        pg8::Gemm g{XS, Wt_1, P, NE * 4096, DM / 2, SC_XS_BYTE, SC_W_BYTE, LD_F8 / 2, LD_F8 / 2}; pg8::MoeTabOrder S{(const LAS int*)tile0 + 128};
        pg8::EpiSwiglu E{(unsigned char*)ACT, b1};
        pg8::gemm_phase<pg8::EpiSwiglu, pg8::MoeTabOrder, true, true, true, true>(lds, g, S, E);
#if defined(PROBE_REP) && PROBE_REP == 7
        __syncthreads(); pg8::gemm_phase<pg8::EpiSwiglu, pg8::MoeOrder, true, true, true>(lds, g, S, E);
#endif
    }
    if (IN(7) && IN(8)) moe_fill_tab(tile0, tile0 + 128, 8, G, vcu);
    SEAM(7);
    if (IN(8)) {
        pg8::Gemm g{ACT, Wt_2, P, NE * 2048, FF / 2, SC_ACT_BYTE, SC_W_BYTE, LD_F8 / 2, LD_F8 / 2}; pg8::MoeTabOrder S{(const LAS int*)tile0 + 128};
        pg8::EpiYs8 E{(unsigned char*)YS, b2};
        pg8::gemm_phase<pg8::EpiYs8, pg8::MoeTabOrder, true, true, true, true>(lds, g, S, E);
#if defined(PROBE_REP) && PROBE_REP == 8
        __syncthreads(); pg8::gemm_phase<pg8::EpiBf16<0>, pg8::MoeOrder, true, true, true>(lds, g, S, E);
#endif
    }
    SEAM(8);
    if (IN(9)) {
#if defined(PROBE_REP) && PROBE_REP == 69
        for (int rep = 0; rep < 2; ++rep)
#endif
        for (int t = gw; t < T; t += NGW) {
            const GAS f32x4* xr = (const GAS f32x4*)(X1 + (size_t)t * DM) + lane;
            f32x4 v[8];
#pragma unroll
            for (int j = 0; j < 8; ++j) v[j] = __builtin_nontemporal_load(xr + 64 * j);
#pragma unroll
            for (int k = 0; k < 4; ++k) { const float gk = r_topg[t * 4 + k] * (1.0f / 16.0f); const GAS int* yr = (const GAS int*)((const unsigned char*)YS + (size_t)r_pos[t * 4 + k] * DM) + lane;
#pragma unroll
                for (int j = 0; j < 8; ++j) { const int y = __builtin_nontemporal_load(yr + 64 * j); typedef float f32x2_t __attribute__((ext_vector_type(2)));
                    const f32x2_t lo = __builtin_amdgcn_cvt_pk_f32_fp8(y, false), hi = __builtin_amdgcn_cvt_pk_f32_fp8(y, true);
                    v[j].x += gk * lo.x; v[j].y += gk * lo.y; v[j].z += gk * hi.x; v[j].w += gk * hi.y; } }
            float s = 0.f;
#pragma unroll
            for (int j = 0; j < 8; ++j) s += (v[j].x * v[j].x + v[j].y * v[j].y) + (v[j].z * v[j].z + v[j].w * v[j].w);
            const float rstd = rsqrtf(wave_sum(s) * (1.f / DM) + NORM_EPS);
            GAS f32x4* orow = (GAS f32x4*)(args.out + (size_t)t * DM) + lane; const GAS f32x4* gr = (const GAS f32x4*)g_final + lane;
#pragma unroll
            for (int j = 0; j < 8; ++j) { const f32x4 gg = gr[64 * j]; __builtin_nontemporal_store((f32x4){v[j].x * rstd * gg.x, v[j].y * rstd * gg.y, v[j].z * rstd * gg.z, v[j].w * rstd * gg.w}, orow + 64 * j); }
        }
    }
#undef IN
#undef SEAM
}

extern "C" void kernel_launch(void* const* d_in, const int* in_sizes, int n_in, void* d_out, int out_size, void* d_ws, size_t ws_size, hipStream_t stream) {
    static int grid = 0;
    if (grid == 0) {
        if (n_in != 25 || out_size != T * DM || ws_size < WS_END) { fprintf(stderr, "kernel_launch: expected 25 inputs, out %d, ws >= %zu; got %d, %d, %zu\n", T * DM, (size_t)WS_END, n_in, out_size, ws_size); grid = -1; return; }
        int dev = 0, cus = 0, per_cu = 0;
        if (hipGetDevice(&dev) != hipSuccess || hipDeviceGetAttribute(&cus, hipDeviceAttributeMultiprocessorCount, dev) != hipSuccess) { grid = -1; return; }
        if (hipFuncSetAttribute((const void*)fwd_kernel, hipFuncAttributeMaxDynamicSharedMemorySize, LDS_BYTES) != hipSuccess) { fprintf(stderr, "kernel_launch: hipFuncSetAttribute failed\n"); grid = -1; return; }
        if (hipOccupancyMaxActiveBlocksPerMultiprocessor(&per_cu, (const void*)fwd_kernel, NWAVES * 64, LDS_BYTES) != hipSuccess || per_cu < 1) { fprintf(stderr, "kernel_launch: occupancy query reports %d blocks per CU\n", per_cu); }
        (void)hipGetLastError();
        grid = cus;
    }
    if (grid < 0) return;
    if (hipMemsetAsync((char*)d_ws + WS_CTL, 0, CTL_ZERO_BYTES, stream) != hipSuccess) { fprintf(stderr, "kernel_launch: memset failed\n"); return; }
    Args a{};
    for (int i = 0; i < 25; ++i) a.in[i] = (const float*)d_in[i];
    a.out = (float*)d_out; a.ws = (unsigned char*)d_ws; a.pad = 0;
#ifndef MK_CUTS
#define MK_CUTS {0, N_PHASES}
#endif
    const int cuts[] = MK_CUTS; const int nl = (int)(sizeof(cuts) / sizeof(int)) - 1;
    for (int li = 0; li < nl; ++li) {
        a.ph_lo = cuts[li]; a.ph_hi = cuts[li + 1]; a.li = li;
        hipLaunchKernelGGL(fwd_kernel, dim3(grid), dim3(NWAVES * 64), LDS_BYTES, stream, a);
        const hipError_t le = hipPeekAtLastError();
        if (le != hipSuccess) { fprintf(stderr, "kernel_launch: launch %d failed: %s\n", li, hipGetErrorName(le)); break; }
    }
}
```
